# Optimizing an MI355X kernel written in HIP

```python
import math
import jax, jax.numpy as jnp
from jax import lax
import numpy as np

D_MODEL = 1024
BATCH = 2
SEQ = 16384
DEPTH = 4

SSM_WIDTH = D_MODEL // 2
SSM_GROUP = 16
SSM_GROUPS = SSM_WIDTH // SSM_GROUP
SSM_STATE = 64
DT_MIN = 1e-3
DT_MAX = 1e-1
N_HEADS = 8
QK_NOPE = 64
QK_ROPE = 32
QK_DIM = QK_NOPE + QK_ROPE
V_DIM = 64
Q_LORA = 256
KV_LORA = 128
ROPE_BASE = 10000.0
Q_BLOCK = 128
D_FF = -(-8 * D_MODEL // (3 * 256)) * 256
N_MOD = 6
EPS = 1e-6
IN_SIZES = (SSM_WIDTH, Q_LORA, KV_LORA, QK_ROPE, D_MODEL, D_MODEL)
IN_COLS = SSM_WIDTH + Q_LORA + KV_LORA + QK_ROPE + 2 * D_MODEL

kernel_name = "hybrid_s5_mla_adaln_trunk"


def rms_norm(x, g):
    xf = x.astype(jnp.float32)
    y = xf * lax.rsqrt(jnp.mean(xf * xf, axis=-1, keepdims=True) + EPS)
    return (y * g.astype(jnp.float32)).astype(x.dtype)


def rope(x, cos, sin):
    x1, x2 = jnp.split(x, 2, axis=-1)
    return jnp.concatenate([x1 * cos - x2 * sin, x2 * cos + x1 * sin], axis=-1)


def _ssm_combine(left, right):
    a1r, a1i, b1r, b1i = left
    a2r, a2i, b2r, b2i = right
    return (a2r * a1r - a2i * a1i,
            a2r * a1i + a2i * a1r,
            a2r * b1r - a2i * b1i + b2r,
            a2r * b1i + a2i * b1r + b2i)


def s5_mixer(u, a_re, a_im, log_dt, b_re, b_im, c_re, c_im, d_skip, w_glu, b_glu):
    f32 = jnp.float32
    bsz, L, _ = u.shape
    dt = jnp.exp(log_dt.astype(f32))[:, None]
    ar = a_re.astype(f32)
    ai = a_im.astype(f32)
    mag = jnp.exp(ar * dt)
    abar_re = mag * jnp.cos(ai * dt)
    abar_im = mag * jnp.sin(ai * dt)
    den = ar * ar + ai * ai
    nr = abar_re - 1.0
    ni = abar_im
    coef_re = ((nr * ar + ni * ai) / den)[..., None]
    coef_im = ((ni * ar - nr * ai) / den)[..., None]
    br = b_re.astype(f32)
    bi = b_im.astype(f32)
    bbar_re = coef_re * br - coef_im * bi
    bbar_im = coef_re * bi + coef_im * br
    ug = u.reshape(bsz, L, SSM_GROUPS, SSM_GROUP).astype(f32)
    bu_re = jnp.einsum('blgm,gpm->blgp', ug, bbar_re)
    bu_im = jnp.einsum('blgm,gpm->blgp', ug, bbar_im)
    a_seq_re = jnp.broadcast_to(abar_re[None, None], (1, L, SSM_GROUPS, SSM_STATE))
    a_seq_im = jnp.broadcast_to(abar_im[None, None], (1, L, SSM_GROUPS, SSM_STATE))
    _, _, h_re, h_im = lax.associative_scan(
        _ssm_combine, (a_seq_re, a_seq_im, bu_re, bu_im), axis=1)
    y = (jnp.einsum('blgp,gmp->blgm', h_re, c_re.astype(f32))
         - jnp.einsum('blgp,gmp->blgm', h_im, c_im.astype(f32))
         + d_skip.astype(f32).reshape(SSM_GROUPS, SSM_GROUP) * ug)
    y = jax.nn.gelu(y.reshape(bsz, L, SSM_WIDTH)).astype(u.dtype)
    return y * jax.nn.sigmoid(y @ w_glu + b_glu)


def mla_mixer(cq_in, ckv_in, kr_in, positions, cos, sin, q_norm_g, w_uq, kv_norm_g, w_uk, w_uv):
    bsz, L, _ = cq_in.shape
    cq = rms_norm(cq_in, q_norm_g)
    q = (cq @ w_uq).reshape(bsz, L, N_HEADS, QK_DIM)
    q = jnp.concatenate([q[..., :QK_NOPE],
                         rope(q[..., QK_NOPE:], cos[:, :, None], sin[:, :, None])], axis=-1)
    ckv = rms_norm(ckv_in, kv_norm_g)
    k_nope = (ckv @ w_uk).reshape(bsz, L, N_HEADS, QK_NOPE)
    v = (ckv @ w_uv).reshape(bsz, L, N_HEADS, V_DIM)
    k_pe = rope(kr_in[:, :, None, :], cos[:, :, None], sin[:, :, None])
    k = jnp.concatenate([k_nope, jnp.broadcast_to(k_pe, (bsz, L, N_HEADS, QK_ROPE))], axis=-1)
    scale = QK_DIM ** -0.5
    nb = L // Q_BLOCK
    qb = q.reshape(bsz, nb, Q_BLOCK, N_HEADS, QK_DIM).transpose(1, 0, 2, 3, 4)
    pb = positions.reshape(bsz, nb, Q_BLOCK).transpose(1, 0, 2)
    neg = jnp.finfo(jnp.float32).min

    def attend_block(args):
        qi, pi = args
        s = jnp.einsum('bqhd,bkhd->bhqk', qi, k).astype(jnp.float32) * scale
        mask = positions[:, None, None, :] <= pi[:, None, :, None]
        p = jax.nn.softmax(jnp.where(mask, s, neg), axis=-1).astype(v.dtype)
        return jnp.einsum('bhqk,bkhd->bqhd', p, v)

    o = lax.map(attend_block, (qb, pb))
    return o.transpose(1, 0, 2, 3, 4).reshape(bsz, L, N_HEADS * V_DIM)


def setup_inputs(seed: int = 0) -> dict:
    key = jax.random.key(seed)
    ks = jax.random.split(key, 32)
    nrm = jax.random.normal
    Lr = DEPTH
    G, P, M = SSM_GROUPS, SSM_STATE, SSM_GROUP
    x = nrm(ks[0], (BATCH, SEQ, D_MODEL), jnp.float32)
    c = nrm(ks[1], (BATCH, D_MODEL), jnp.float32)
    offset = jax.random.randint(ks[2], (BATCH, 1), 0, 4096, dtype=jnp.int32)
    positions = offset + jnp.arange(SEQ, dtype=jnp.int32)[None, :]
    n_idx = jnp.arange(P, dtype=jnp.float32)
    inv2 = 0.5 ** 0.5
    return {
        "x": x,
        "c": c,
        "positions": positions,
        "w_ada": nrm(ks[3], (Lr, D_MODEL, N_MOD * D_MODEL)) * (0.5 * D_MODEL ** -0.5),
        "b_ada": nrm(ks[4], (Lr, N_MOD * D_MODEL)) * 0.01,
        "norm1_g": 1.0 + 0.01 * nrm(ks[5], (Lr, D_MODEL)),
        "w_in": nrm(ks[6], (Lr, D_MODEL, IN_COLS)) * D_MODEL ** -0.5,
        "ssm_a_re": -0.5 * jnp.exp(0.02 * nrm(ks[7], (Lr, G, P))),
        "ssm_a_im": math.pi * n_idx[None, None, :] + 0.01 * nrm(ks[8], (Lr, G, P)),
        "ssm_log_dt": jax.random.uniform(ks[9], (Lr, G), jnp.float32, math.log(DT_MIN), math.log(DT_MAX)),
        "ssm_b_re": nrm(ks[10], (Lr, G, P, M)) * (inv2 * M ** -0.5),
        "ssm_b_im": nrm(ks[11], (Lr, G, P, M)) * (inv2 * M ** -0.5),
        "ssm_c_re": nrm(ks[12], (Lr, G, M, P)) * (inv2 * P ** -0.5),
        "ssm_c_im": nrm(ks[13], (Lr, G, M, P)) * (inv2 * P ** -0.5),
        "ssm_d": nrm(ks[14], (Lr, SSM_WIDTH)),
        "w_glu": nrm(ks[15], (Lr, SSM_WIDTH, SSM_WIDTH)) * SSM_WIDTH ** -0.5,
        "b_glu": nrm(ks[16], (Lr, SSM_WIDTH)) * 0.01,
        "w_a_out": nrm(ks[17], (Lr, SSM_WIDTH, D_MODEL)) * SSM_WIDTH ** -0.5,
        "q_norm_g": 1.0 + 0.01 * nrm(ks[18], (Lr, Q_LORA)),
        "w_uq": nrm(ks[19], (Lr, Q_LORA, N_HEADS * QK_DIM)) * Q_LORA ** -0.5,
        "kv_norm_g": 1.0 + 0.01 * nrm(ks[20], (Lr, KV_LORA)),
        "w_uk": nrm(ks[21], (Lr, KV_LORA, N_HEADS * QK_NOPE)) * KV_LORA ** -0.5,
        "w_uv": nrm(ks[22], (Lr, KV_LORA, N_HEADS * V_DIM)) * KV_LORA ** -0.5,
        "w_b_out": nrm(ks[23], (Lr, N_HEADS * V_DIM, D_MODEL)) * (N_HEADS * V_DIM) ** -0.5,
        "w_out": nrm(ks[24], (Lr, D_MODEL, D_MODEL)) * D_MODEL ** -0.5,
        "norm2_g": 1.0 + 0.01 * nrm(ks[25], (Lr, D_MODEL)),
        "w_gate": nrm(ks[26], (Lr, D_MODEL, D_FF)) * D_MODEL ** -0.5,
        "w_up": nrm(ks[27], (Lr, D_MODEL, D_FF)) * D_MODEL ** -0.5,
        "w_down": nrm(ks[28], (Lr, D_FF, D_MODEL)) * D_FF ** -0.5,
        "final_g": 1.0 + 0.01 * nrm(ks[29], (D_MODEL,)),
    }


def reference(x, c, positions, w_ada, b_ada, norm1_g, w_in, ssm_a_re, ssm_a_im, ssm_log_dt,
              ssm_b_re, ssm_b_im, ssm_c_re, ssm_c_im, ssm_d, w_glu, b_glu, w_a_out,
              q_norm_g, w_uq, kv_norm_g, w_uk, w_uv, w_b_out, w_out, norm2_g,
              w_gate, w_up, w_down, final_g):
    inv_freq = ROPE_BASE ** (-jnp.arange(0, QK_ROPE, 2, dtype=jnp.float32) / QK_ROPE)
    ang = positions.astype(jnp.float32)[..., None] * inv_freq
    cos = jnp.cos(ang).astype(x.dtype)
    sin = jnp.sin(ang).astype(x.dtype)
    split_pts = [int(s) for s in np.cumsum(IN_SIZES)[:-1]]
    c_act = jax.nn.silu(c)
    for l in range(DEPTH):
        mod = (c_act @ w_ada[l] + b_ada[l])[:, None, :]
        sh1, sc1, g1, sh2, sc2, g2 = jnp.split(mod, N_MOD, axis=-1)
        h = rms_norm(x, norm1_g[l]) * (1.0 + sc1) + sh1
        z = h @ w_in[l]
        u, cq_in, ckv_in, kr_in, gate_a, gate_b = jnp.split(z, split_pts, axis=-1)
        y_a = s5_mixer(u, ssm_a_re[l], ssm_a_im[l], ssm_log_dt[l], ssm_b_re[l], ssm_b_im[l],
                       ssm_c_re[l], ssm_c_im[l], ssm_d[l], w_glu[l], b_glu[l]) @ w_a_out[l]
        y_b = mla_mixer(cq_in, ckv_in, kr_in, positions, cos, sin, q_norm_g[l], w_uq[l],
                        kv_norm_g[l], w_uk[l], w_uv[l]) @ w_b_out[l]
        merged = jax.nn.sigmoid(gate_a) * y_a + jax.nn.sigmoid(gate_b) * y_b
        x = x + g1 * (merged @ w_out[l])
        h = rms_norm(x, norm2_g[l]) * (1.0 + sc2) + sh2
        x = x + g2 * ((jax.nn.silu(h @ w_gate[l]) * (h @ w_up[l])) @ w_down[l])
    return rms_norm(x, final_g)
```

```cpp
#include <hip/hip_runtime.h>
#include <hip/hip_cooperative_groups.h>
#include <cstdio>
#include <cstdint>
#include <cstddef>
namespace cg = cooperative_groups;

#define LAS __attribute__((address_space(3)))
typedef unsigned short bf16_t;
typedef short bf16x8 __attribute__((ext_vector_type(8)));
typedef short s16x4 __attribute__((ext_vector_type(4)));
typedef float f32x4 __attribute__((ext_vector_type(4)));
typedef float f32x2 __attribute__((ext_vector_type(2)));
typedef float f32x16 __attribute__((ext_vector_type(16)));
typedef unsigned u32x4 __attribute__((ext_vector_type(4)));
typedef unsigned u32x2 __attribute__((ext_vector_type(2)));
typedef int i32x4 __attribute__((ext_vector_type(4)));

constexpr int D = 1024, BATCH = 2, SEQ = 16384, T = BATCH * SEQ, DEPTH = 4;
constexpr int SW = 512, NG = 32, SP = 64;
constexpr int NH = 8, QKD = 96, QL = 256, KVL = 128;
constexpr int DFF = 2816, INC = 2976;
constexpr int NCH = T / 64;
constexpr float EPS = 1e-6f;

constexpr size_t MiB = 1u << 20;
constexpr size_t WS_MOD = 0, WS_TPOS = 1 * MiB, WS_ROPE = 2 * MiB, WS_APOW = 6 * MiB, WS_BBAR = 8 * MiB, WS_KG = 9 * MiB, WS_ET = 11 * MiB, WS_FT = 19 * MiB,
                 WS_S = 28 * MiB, WS_HC = 36 * MiB, WS_W = 40 * MiB, WS_H = 68 * MiB, WS_UG = 132 * MiB, WS_ZX = 164 * MiB, WS_GATES = 196 * MiB, WS_Q = 324 * MiB,
                 WS_KN = 372 * MiB, WS_KPE = 404 * MiB, WS_VT = 406 * MiB, WS_O = 438 * MiB, WS_YPART = 470 * MiB, WS_END = 502 * MiB;
constexpr size_t WS_BAR = 1 * MiB + 65536;
constexpr size_t WS_YA = WS_ZX, WS_YG = WS_Q, WS_HID = WS_GATES;
constexpr size_t WO_IN = 0, WO_GLU = WO_IN + 3072 * 1024, WO_A = WO_GLU + 512 * 512, WO_B = WO_A + 1024 * 512, WO_UQ = WO_B + 1024 * 512, WO_UK = WO_UQ + 768 * 256,
                 WO_UV = WO_UK + 512 * 128, WO_OUT = WO_UV + 512 * 128, WO_GU = WO_OUT + 1024 * 1024, WO_DOWN = WO_GU + 5632 * 1024, WO_END = WO_DOWN + 1024 * 2816;
static_assert(WO_END * 2 <= 28 * MiB, "weight region");

struct Params {
    const float* in[30];
    float* out;
    unsigned char* ws;
};

typedef __bf16 bf16x2_t __attribute__((ext_vector_type(2)));
__device__ __forceinline__ unsigned cvt_pk_bf16(float lo, float hi) { f32x2 v = {lo, hi}; bf16x2_t b = __builtin_convertvector(v, bf16x2_t); return __builtin_bit_cast(unsigned, b); }
__device__ __forceinline__ bf16_t f2bf(float f) { unsigned u = __builtin_bit_cast(unsigned, f); return (bf16_t)((u + 0x7fffu + ((u >> 16) & 1u)) >> 16); }
__device__ __forceinline__ float bf2f(unsigned short h) { return __builtin_bit_cast(float, (unsigned)h << 16); }
__device__ __forceinline__ float bflo(unsigned w) { return __builtin_bit_cast(float, w << 16); }
__device__ __forceinline__ float bfhi(unsigned w) { return __builtin_bit_cast(float, w & 0xffff0000u); }
__device__ __forceinline__ float sigmoidf_(float x) { return __builtin_amdgcn_rcpf(1.0f + __expf(-x)); }
__device__ __forceinline__ float gelu_tanh(float x) { const float z = 1.5957691216f * (x + 0.044715f * x * x * x); return x * sigmoidf_(z); }
__device__ __forceinline__ u32x4 pack8(const f32x4 a, const f32x4 b) { u32x4 w; w.x = cvt_pk_bf16(a[0], a[1]); w.y = cvt_pk_bf16(a[2], a[3]); w.z = cvt_pk_bf16(b[0], b[1]); w.w = cvt_pk_bf16(b[2], b[3]); return w; }
__device__ __forceinline__ void unpack8(const u32x4 w, f32x4& a, f32x4& b) { a = (f32x4){bflo(w.x), bfhi(w.x), bflo(w.y), bfhi(w.y)}; b = (f32x4){bflo(w.z), bfhi(w.z), bflo(w.w), bfhi(w.w)}; }
__device__ __forceinline__ float shflx(float v, int o, int lane) { return __builtin_bit_cast(float, __builtin_amdgcn_ds_bpermute((lane ^ o) << 2, __builtin_bit_cast(int, v))); }
__device__ __forceinline__ int shflxi(int v, int o, int lane) { return __builtin_amdgcn_ds_bpermute((lane ^ o) << 2, v); }
__device__ __forceinline__ float wave_sum(float v, int lane) {
#pragma unroll
    for (int o = 1; o < 64; o <<= 1) v += shflx(v, o, lane);
    return v;
}

namespace pg8 {
constexpr int BM = 256, BK = 64, HALF = 128, HTB = HALF * BK * 2, STAGE_BYTES = 8 * HTB, NXCD = 8, WGM = 8;
__device__ __forceinline__ int lds_byte(int r, int c) { const int st = (r >> 4) * 2 + (c >> 5), rr = r & 15, cc = c & 31, ob = rr * 64 + cc * 2; return st * 1024 + (ob ^ (((ob >> 9) & 1) << 5)); }
__device__ __forceinline__ void stage_rc(int b, int& R, int& C) { const int st = b / 1024, sb = b % 1024, swz = sb ^ (((sb >> 9) & 1) << 5); R = (st >> 1) * 16 + swz / 64; C = (st & 1) * 32 + (swz % 64) / 2; }
__device__ __forceinline__ int perm32(int rho) { const int n = rho >> 4, i = rho & 15; return 8 * (i >> 2) + 4 * n + (i & 3); }

struct Unit { int g, pm, pn; };
struct Gemm { const bf16_t* A; const bf16_t* Bt; int lda, ldb; size_t gsA, gsB; int K; };

struct Order {
    int nM, nN, per, total, G, c;
    __device__ void init(int M, int N, int groups, int G_, int c_) { nM = M / BM; nN = N / BM; per = nM * nN; total = per * groups; G = G_; c = c_; }
    __device__ bool next(int i, Unit& u) const {
        const int L = i * G + c; if (L >= total) return false;
        const int grp = L / per; int wgid = L - grp * per;
        { const int q = per / NXCD, r = per % NXCD, xcd = wgid % NXCD, off = wgid / NXCD; wgid = (xcd < r ? xcd * (q + 1) : r * (q + 1) + (xcd - r) * q) + off; }
        const int nig = WGM * nN, gid = wgid / nig, fm = gid * WGM, gsz = (nM - fm) < WGM ? (nM - fm) : WGM;
        u.g = grp; u.pm = fm + ((wgid % nig) % gsz); u.pn = (wgid % nig) / gsz; return true;
    }
};

template <class Epi, bool TOEP>
__device__ __forceinline__ void gemm_phase(LAS unsigned char* lds, const Gemm g, const Order& S, const Epi& E) {
    int tid_ = threadIdx.x; asm volatile("" : "+v"(tid_));
    const int tid = tid_, wid = __builtin_amdgcn_readfirstlane(tid >> 6), lane = tid & 63, wr = wid >> 2, wc = wid & 3, fr = lane & 15, fq = lane >> 4;
    const int K = g.K, nt = K / BK;
    unsigned voffA[2], voffB[2];
#pragma unroll
    for (int i = 0; i < 2; ++i) { int R, C; stage_rc(tid * 16 + i * 8192, R, C); const int Rb = (R & ~31) + perm32(R & 31);
        voffA[i] = (unsigned)(R * g.lda + C) * 2u; voffB[i] = TOEP ? (unsigned)(Rb * g.ldb + (C & 15) - (C >> 4) * 256 + 768) * 2u : (unsigned)(Rb * g.ldb + C) * 2u; }
    const ptrdiff_t kstepA = (ptrdiff_t)(BK * 2), kstepB = TOEP ? (ptrdiff_t)-2048 : (ptrdiff_t)(BK * 2);
    const ptrdiff_t hstepA = (ptrdiff_t)HALF * g.lda * 2, hstepB = (ptrdiff_t)HALF * g.ldb * 2;
    const unsigned ldsb = (unsigned)(size_t)lds + (unsigned)wid * 1024u;
    const int aoff = lds_byte(wr * 64 + fr, fq * 8), boff = lds_byte(wc * 32 + fr, fq * 8);
#define PG8_UA(u) ((const char*)g.A + ((size_t)(u).g * g.gsA + (size_t)(u).pm * BM * g.lda) * 2)
#define PG8_UB(u) ((const char*)g.Bt + ((size_t)(u).g * g.gsB + (size_t)(u).pn * BM * g.ldb) * 2 - (TOEP ? 1536 : 0))
#define PG8_SA(b, h) (((b) * 2 + (h)) * HTB)
#define PG8_SB(b, h) ((4 + (b) * 2 + (h)) * HTB)
#define PG8_STAGE(bufoff, gbase, voff) do { _Pragma("unroll") for (int _i = 0; _i < 2; ++_i) { unsigned keep_; \
        asm volatile("s_mov_b32 %0, m0\n\ts_mov_b32 m0, %3\n\ts_nop 0\n\tglobal_load_lds_dwordx4 %1, %2\n\ts_mov_b32 m0, %0" : "=&s"(keep_) : "v"((voff)[_i]), "s"((const char*)(gbase)), "s"(ldsb + (unsigned)((bufoff) + _i * 8192)) : "memory"); } } while (0)
#define PG8_LDA(dst, b, h) do { _Pragma("unroll") for (int m = 0; m < 4; ++m) _Pragma("unroll") for (int k = 0; k < 2; ++k) dst[m][k] = *(const LAS bf16x8*)(lds + PG8_SA(b, h) + aoff + m * 2048 + k * 1024); } while (0)
#define PG8_LDB(dst, b, h) do { _Pragma("unroll") for (int n = 0; n < 2; ++n) _Pragma("unroll") for (int k = 0; k < 2; ++k) dst[n][k] = *(const LAS bf16x8*)(lds + PG8_SB(b, h) + boff + n * 2048 + k * 1024); } while (0)
#define PG8_MMA(ai, bj, At, Bt) do { __builtin_amdgcn_s_setprio(1); _Pragma("unroll") for (int m = 0; m < 4; ++m) _Pragma("unroll") for (int n = 0; n < 2; ++n) _Pragma("unroll") for (int k = 0; k < 2; ++k) \
        acc[ai][bj][m][n] = __builtin_amdgcn_mfma_f32_16x16x32_bf16(Bt[n][k], At[m][k], acc[ai][bj][m][n], 0, 0, 0); __builtin_amdgcn_s_setprio(0); } while (0)
#define PG8_WAIT_V(n) asm volatile("s_waitcnt vmcnt(" #n ")" ::: "memory")
#define PG8_WAIT_L(n) asm volatile("s_waitcnt lgkmcnt(" #n ")" ::: "memory")
#define PG8_BAR __builtin_amdgcn_s_barrier()
#define PG8_SCHED __builtin_amdgcn_sched_barrier(0)
    Unit cur, nxt; int ui = 0;
    if (!S.next(0, cur)) return;
    f32x4 acc[2][2][4][2];
#pragma unroll
    for (int a = 0; a < 2; ++a)
#pragma unroll
        for (int b = 0; b < 2; ++b)
#pragma unroll
            for (int m = 0; m < 4; ++m)
#pragma unroll
                for (int n = 0; n < 2; ++n) acc[a][b][m][n] = (f32x4){0.f, 0.f, 0.f, 0.f};
    bf16x8 At[4][2], B0[2][2], B1[2][2];
    const char* cA = PG8_UA(cur); const char* cB = PG8_UB(cur);
    PG8_STAGE(PG8_SB(0, 0), cB, voffB); PG8_STAGE(PG8_SB(0, 1), cB + hstepB, voffB); PG8_STAGE(PG8_SA(0, 0), cA, voffA); PG8_STAGE(PG8_SA(0, 1), cA + hstepA, voffA);
    if (wr == 1) PG8_BAR;
    PG8_WAIT_V(2); PG8_BAR;
    PG8_STAGE(PG8_SB(1, 0), cB + kstepB, voffB); PG8_STAGE(PG8_SA(1, 0), cA + kstepA, voffA); PG8_STAGE(PG8_SB(1, 1), cB + hstepB + kstepB, voffB);
    PG8_WAIT_V(6); PG8_BAR;
    for (;;) {
        const bool has_next = S.next(ui + 1, nxt);
        const char* nA = has_next ? PG8_UA(nxt) : cA; const char* nB = has_next ? PG8_UB(nxt) : cB;
        for (int t = 0; t < nt; t += 2) {
            const bool last = (t == nt - 2);
            asm volatile("" : "+v"(voffA[0]), "+v"(voffA[1]), "+v"(voffB[0]), "+v"(voffB[1]));
            const char* a1 = cA + (ptrdiff_t)(t + 1) * kstepA;
            const char* a2 = last ? nA : cA + (ptrdiff_t)(t + 2) * kstepA; const char* b2 = last ? nB : cB + (ptrdiff_t)(t + 2) * kstepB;
            const char* a3 = a2 + kstepA; const char* b3 = b2 + kstepB;
            PG8_LDB(B0, 0, 0); PG8_LDB(B1, 0, 1); PG8_SCHED; PG8_LDA(At, 0, 0); PG8_STAGE(PG8_SA(1, 1), a1 + hstepA, voffA);
            PG8_WAIT_V(8); PG8_WAIT_L(0); PG8_BAR; PG8_MMA(0, 0, At, B0); PG8_MMA(0, 1, At, B1); PG8_BAR; PG8_SCHED;
            PG8_LDA(At, 0, 1); PG8_STAGE(PG8_SB(0, 0), b2, voffB); PG8_STAGE(PG8_SB(0, 1), b2 + hstepB, voffB); PG8_STAGE(PG8_SA(0, 0), a2, voffA);
            PG8_WAIT_V(8); PG8_WAIT_L(0); PG8_BAR; PG8_MMA(1, 0, At, B0); PG8_MMA(1, 1, At, B1); PG8_BAR; PG8_SCHED;
            PG8_LDB(B0, 1, 0); PG8_LDB(B1, 1, 1); PG8_SCHED; PG8_LDA(At, 1, 0); PG8_STAGE(PG8_SA(0, 1), a2 + hstepA, voffA);
            PG8_WAIT_V(8); PG8_WAIT_L(0); PG8_BAR; PG8_MMA(0, 0, At, B0); PG8_MMA(0, 1, At, B1); PG8_BAR; PG8_SCHED;
            PG8_LDA(At, 1, 1); PG8_STAGE(PG8_SB(1, 0), b3, voffB); PG8_STAGE(PG8_SB(1, 1), b3 + hstepB, voffB); PG8_STAGE(PG8_SA(1, 0), a3, voffA);
            PG8_WAIT_V(8); PG8_WAIT_L(0); PG8_BAR; PG8_MMA(1, 0, At, B0); PG8_MMA(1, 1, At, B1); PG8_BAR; PG8_SCHED;
        }
        if (wr == 0) PG8_BAR;
        { int frx = fr, fqx = fq; asm volatile("" : "+v"(frx), "+v"(fqx)); E(acc, cur, wr, wc, frx, fqx); }
        if (!has_next) break;
#pragma unroll
        for (int a = 0; a < 2; ++a)
#pragma unroll
            for (int b = 0; b < 2; ++b)
#pragma unroll
                for (int m = 0; m < 4; ++m)
#pragma unroll
                    for (int n = 0; n < 2; ++n) acc[a][b][m][n] = (f32x4){0.f, 0.f, 0.f, 0.f};
        cur = nxt; cA = nA; cB = nB; ++ui;
        if (wr == 1) PG8_BAR;
    }
    PG8_WAIT_V(0);
    PG8_BAR;
#undef PG8_UA
#undef PG8_UB
#undef PG8_SA
#undef PG8_SB
#undef PG8_STAGE
#undef PG8_LDA
#undef PG8_LDB
#undef PG8_MMA
#undef PG8_WAIT_V
#undef PG8_WAIT_L
#undef PG8_BAR
#undef PG8_SCHED
}

#define EPI_BEGIN \
    _Pragma("unroll") for (int ai = 0; ai < 2; ++ai) _Pragma("unroll") for (int m = 0; m < 4; ++m) { \
        const int row = u.pm * 256 + ai * 128 + wr * 64 + m * 16 + fr; \
        _Pragma("unroll") for (int bj = 0; bj < 2; ++bj) { \
            const int col = u.pn * 256 + bj * 128 + wc * 32 + 8 * fq; \
            f32x4 v0 = acc[ai][bj][m][0], v1 = acc[ai][bj][m][1];
#define EPI_END } asm volatile("" ::: "memory"); }
#define EPI_SIG const f32x4 (&acc)[2][2][4][2], const Unit& u, int wr, int wc, int fr, int fq

struct EpiStore { bf16_t* O; size_t gs; int ldc;
    __device__ __forceinline__ void operator()(EPI_SIG) const {
        EPI_BEGIN *(u32x4*)(O + (size_t)u.g * gs + (size_t)row * ldc + col) = pack8(v0, v1); EPI_END } };
struct EpiIn { bf16_t* Ug; bf16_t* zx; bf16_t* gates;
    __device__ __forceinline__ void operator()(EPI_SIG) const {
        if (u.pn < 2) { EPI_BEGIN *(u32x4*)(Ug + ((size_t)((col >> 4) * NCH + (row >> 6)) * 1024 + (row & 63) * 16 + (col & 15))) = pack8(v0, v1); EPI_END }
        else if (u.pn < 4) { EPI_BEGIN *(u32x4*)(zx + (size_t)row * 512 + (col - 512)) = pack8(v0, v1); EPI_END }
        else { EPI_BEGIN
#pragma unroll
            for (int i = 0; i < 4; ++i) { v0[i] = sigmoidf_(v0[i]); v1[i] = sigmoidf_(v1[i]); }
            *(u32x4*)(gates + (size_t)row * 2048 + (col - 1024)) = pack8(v0, v1); EPI_END } } };
struct EpiQ { bf16_t* Q; const float* cosT; const float* sinT; float scale;
    __device__ __forceinline__ void operator()(EPI_SIG) const {
        EPI_BEGIN
            const int head = col / 96, d = col - head * 96;
            v0 = v0 * scale; v1 = v1 * scale;
            if (d >= 64) { const int i0 = (d - 64) >> 1; const f32x4 c4 = *(const f32x4*)(cosT + (size_t)row * 16 + i0), s4 = *(const f32x4*)(sinT + (size_t)row * 16 + i0);
                const f32x4 a = v0, b = v1;
                v0[0] = a[0] * c4[0] - a[1] * s4[0]; v0[1] = a[1] * c4[0] + a[0] * s4[0]; v0[2] = a[2] * c4[1] - a[3] * s4[1]; v0[3] = a[3] * c4[1] + a[2] * s4[1];
                v1[0] = b[0] * c4[2] - b[1] * s4[2]; v1[1] = b[1] * c4[2] + b[0] * s4[2]; v1[2] = b[2] * c4[3] - b[3] * s4[3]; v1[3] = b[3] * c4[3] + b[2] * s4[3]; }
            *(u32x4*)(Q + (size_t)row * 768 + col) = pack8(v0, v1);
        EPI_END } };
struct EpiS { float* S;
    __device__ __forceinline__ void operator()(EPI_SIG) const {
        EPI_BEGIN if (bj == 0) { float* p = S + ((size_t)u.g * NCH + row) * 128 + col; *(f32x4*)p = v0; *(f32x4*)(p + 4) = v1; } EPI_END } };
struct EpiE { const bf16_t* ypart; const bf16_t* Ug; const float* dskip; bf16_t* ya;
    __device__ __forceinline__ void operator()(EPI_SIG) const {
        EPI_BEGIN
            const size_t off = ((size_t)u.g * NCH + row) * 1024 + col;
            f32x4 p0, p1, u0, u1; unpack8(*(const u32x4*)(ypart + off), p0, p1); unpack8(*(const u32x4*)(Ug + off), u0, u1);
            const float* dp = dskip + u.g * 16 + (col & 15); const f32x4 d0 = *(const f32x4*)dp, d1 = *(const f32x4*)(dp + 4);
            v0 = v0 + p0 + d0 * u0; v1 = v1 + p1 + d1 * u1;
#pragma unroll
            for (int i = 0; i < 4; ++i) { v0[i] = gelu_tanh(v0[i]); v1[i] = gelu_tanh(v1[i]); }
            *(u32x4*)(ya + ((size_t)row * 64 + (col >> 4)) * 512 + u.g * 16 + (col & 15)) = pack8(v0, v1);
        EPI_END } };
struct EpiGlu { const bf16_t* ya; const float* bias; bf16_t* yg;
    __device__ __forceinline__ void operator()(EPI_SIG) const {
        EPI_BEGIN
            f32x4 y0, y1; unpack8(*(const u32x4*)(ya + (size_t)row * 512 + col), y0, y1);
            const f32x4 b0 = *(const f32x4*)(bias + col), b1 = *(const f32x4*)(bias + col + 4);
#pragma unroll
            for (int i = 0; i < 4; ++i) { v0[i] = y0[i] * sigmoidf_(v0[i] + b0[i]); v1[i] = y1[i] * sigmoidf_(v1[i] + b1[i]); }
            *(u32x4*)(yg + (size_t)row * 512 + col) = pack8(v0, v1);
        EPI_END } };
template <bool ACCUM> struct EpiMerge { const bf16_t* gates; int goff; bf16_t* mg;
    __device__ __forceinline__ void operator()(EPI_SIG) const {
        EPI_BEGIN
            f32x4 g0, g1; unpack8(*(const u32x4*)(gates + (size_t)row * 2048 + goff + col), g0, g1);
            v0 = v0 * g0; v1 = v1 * g1;
            if (ACCUM) { f32x4 o0, o1; unpack8(*(const u32x4*)(mg + (size_t)row * 1024 + col), o0, o1); v0 = v0 + o0; v1 = v1 + o1; }
            *(u32x4*)(mg + (size_t)row * 1024 + col) = pack8(v0, v1);
        EPI_END } };
struct EpiRes { const float* xin; float* xout; const float* gmod;
    __device__ __forceinline__ void operator()(EPI_SIG) const {
        EPI_BEGIN
            const float* gp = gmod + (row >= SEQ ? 6144 : 0) + col; const f32x4 g0 = *(const f32x4*)gp, g1 = *(const f32x4*)(gp + 4);
            const float* xp = xin + (size_t)row * 1024 + col; float* op = xout + (size_t)row * 1024 + col;
            const f32x4 x0 = *(const f32x4*)xp, x1 = *(const f32x4*)(xp + 4);
            *(f32x4*)op = x0 + g0 * v0; *(f32x4*)(op + 4) = x1 + g1 * v1;
        EPI_END } };
struct EpiGU { bf16_t* hid;
    __device__ __forceinline__ void operator()(EPI_SIG) const {
        EPI_BEGIN
#pragma unroll
            for (int i = 0; i < 4; ++i) v0[i] = v0[i] * sigmoidf_(v0[i]) * v1[i];
            u32x2 w; w.x = cvt_pk_bf16(v0[0], v0[1]); w.y = cvt_pk_bf16(v0[2], v0[3]);
            *(u32x2*)(hid + (size_t)row * DFF + (col >> 1)) = w;
        EPI_END } };
}

namespace att {
constexpr int KSTR = 208, VSTR = 136, KBUF = 64 * KSTR, VBUF = 64 * VSTR, OFF_V = 2 * KBUF, OFF_P = OFF_V + 2 * VBUF, LDS_BYTES = OFF_P + 512;
constexpr float NEG = -1.0e30f;

__device__ __forceinline__ void phase(LAS unsigned char* lds, const bf16_t* __restrict__ Q, const bf16_t* __restrict__ Kn, const bf16_t* __restrict__ Kpe, const bf16_t* __restrict__ Vt,
                                      bf16_t* __restrict__ O, const int* __restrict__ pos, const int* __restrict__ tmin, const int* __restrict__ tmax, int G, int c) {
    int tid_ = threadIdx.x; asm volatile("" : "+v"(tid_));
    const int tid = tid_, wave = __builtin_amdgcn_readfirstlane(tid >> 6), lane = tid & 63, q32 = lane & 31, hi = lane >> 5;
    for (int ui = c; ui < 1024; ui += G) {
        const int rnd = ui >> 8, cc = ui & 255, bh = cc >> 4, j16 = cc & 15;
        const int qb = rnd == 0 ? 63 - j16 : rnd == 1 ? 32 + j16 : rnd == 2 ? 31 - j16 : j16;
        const int b = bh >> 3, h = bh & 7;
        const int* tmn = tmin + b * 256; const int* tmx = tmax + b * 256;
        int qmax = tmx[qb * 4], qmin = tmn[qb * 4];
#pragma unroll
        for (int i = 1; i < 4; ++i) { qmax = max(qmax, tmx[qb * 4 + i]); qmin = min(qmin, tmn[qb * 4 + i]); }
        const size_t tok0 = (size_t)b * SEQ;
        const size_t qrow = tok0 + qb * 256 + wave * 32 + q32;
        bf16x8 qf[6];
        { const bf16_t* qp = Q + qrow * 768 + h * 96 + 8 * hi;
#pragma unroll
          for (int j = 0; j < 6; ++j) qf[j] = *(const bf16x8*)(qp + 16 * j); }
        const int posq = pos[qrow];
        f32x16 o0, o1;
#pragma unroll
        for (int r = 0; r < 16; ++r) { o0[r] = 0.f; o1[r] = 0.f; }
        float mrun = NEG, lrun = 0.f;
        const int krow = tid >> 3, kpc = tid & 7, prow = (tid & 255) >> 2, ppc = tid & 3;
        const bf16_t* kn_src = Kn + (tok0 + krow) * 512 + h * 64 + kpc * 8;
        const bf16_t* kp_src = Kpe + (tok0 + prow) * 32 + ppc * 8;
        const bf16_t* vt_src = Vt + (size_t)(h * 64 + krow) * T + tok0 + kpc * 8;
        const int* ps_src = pos + tok0 + (tid & 63);
        u32x4 rk, rp, rv; int rpos = 0;
        rp = (u32x4){0u, 0u, 0u, 0u};
#define ATT_LOAD(kt_) do { rk = *(const u32x4*)(kn_src + (size_t)(kt_) * 64 * 512); if (tid < 256) rp = *(const u32x4*)(kp_src + (size_t)(kt_) * 64 * 32); \
        rv = *(const u32x4*)(vt_src + (size_t)(kt_) * 64); if (tid < 64) rpos = ps_src[(kt_) * 64]; } while (0)
#define ATT_STORE(bf_) do { *(LAS u32x4*)(lds + (bf_) * KBUF + krow * KSTR + kpc * 16) = rk; if (tid < 256) *(LAS u32x4*)(lds + (bf_) * KBUF + prow * KSTR + 128 + ppc * 16) = rp; \
        LAS unsigned char* vp_ = lds + OFF_V + (bf_) * VBUF + krow * VSTR + kpc * 16; *(LAS u32x2*)vp_ = (u32x2){rv.x, rv.y}; *(LAS u32x2*)(vp_ + 8) = (u32x2){rv.z, rv.w}; \
        if (tid < 64) *(LAS int*)(lds + OFF_P + (bf_) * 256 + tid * 4) = rpos; } while (0)
        int kt = 0;
        while (kt < 256 && tmn[kt] > qmax) ++kt;
        if (kt < 256) { ATT_LOAD(kt); ATT_STORE(0); }
        __syncthreads();
        int buf = 0;
        while (kt < 256) {
            int ktn = kt + 1;
            while (ktn < 256 && tmn[ktn] > qmax) ++ktn;
            if (ktn < 256) ATT_LOAD(ktn);
            const bool need_mask = tmx[kt] > qmin;
            f32x16 s0, s1;
#pragma unroll
            for (int r = 0; r < 16; ++r) { s0[r] = 0.f; s1[r] = 0.f; }
            { const LAS unsigned char* kb = lds + buf * KBUF + q32 * KSTR + hi * 16;
#pragma unroll
              for (int j = 0; j < 6; ++j) {
                  const bf16x8 a0 = *(const LAS bf16x8*)(kb + j * 32);
                  const bf16x8 a1 = *(const LAS bf16x8*)(kb + 32 * KSTR + j * 32);
                  s0 = __builtin_amdgcn_mfma_f32_32x32x16_bf16(a0, qf[j], s0, 0, 0, 0);
                  s1 = __builtin_amdgcn_mfma_f32_32x32x16_bf16(a1, qf[j], s1, 0, 0, 0); } }
            if (need_mask) {
                const LAS int* pp = (const LAS int*)(lds + OFF_P + buf * 256) + 4 * hi;
#pragma unroll
                for (int i = 0; i < 4; ++i) {
                    const i32x4 p0 = *(const LAS i32x4*)(pp + 8 * i), p1 = *(const LAS i32x4*)(pp + 32 + 8 * i);
#pragma unroll
                    for (int e = 0; e < 4; ++e) { if (p0[e] > posq) s0[4 * i + e] = NEG; if (p1[e] > posq) s1[4 * i + e] = NEG; } }
            }
            float mx = fmaxf(s0[0], s1[0]);
#pragma unroll
            for (int r = 1; r < 16; ++r) mx = fmaxf(mx, fmaxf(s0[r], s1[r]));
            mx = fmaxf(mx, shflx(mx, 32, lane));
            const float mnew = fmaxf(mrun, mx);
            const float alpha = __builtin_amdgcn_exp2f(mrun - mnew);
            mrun = mnew;
            float ls = 0.f;
#pragma unroll
            for (int r = 0; r < 16; ++r) { s0[r] = __builtin_amdgcn_exp2f(s0[r] - mnew); s1[r] = __builtin_amdgcn_exp2f(s1[r] - mnew); ls += s0[r] + s1[r]; }
            lrun = lrun * alpha + ls;
#pragma unroll
            for (int r = 0; r < 16; ++r) { o0[r] *= alpha; o1[r] *= alpha; }
            bf16x8 pb[2][2];
#pragma unroll
            for (int jj = 0; jj < 2; ++jj) {
                u32x4 w0, w1;
                w0.x = cvt_pk_bf16(s0[8 * jj + 0], s0[8 * jj + 1]); w0.y = cvt_pk_bf16(s0[8 * jj + 2], s0[8 * jj + 3]); w0.z = cvt_pk_bf16(s0[8 * jj + 4], s0[8 * jj + 5]); w0.w = cvt_pk_bf16(s0[8 * jj + 6], s0[8 * jj + 7]);
                w1.x = cvt_pk_bf16(s1[8 * jj + 0], s1[8 * jj + 1]); w1.y = cvt_pk_bf16(s1[8 * jj + 2], s1[8 * jj + 3]); w1.z = cvt_pk_bf16(s1[8 * jj + 4], s1[8 * jj + 5]); w1.w = cvt_pk_bf16(s1[8 * jj + 6], s1[8 * jj + 7]);
                pb[0][jj] = __builtin_bit_cast(bf16x8, w0); pb[1][jj] = __builtin_bit_cast(bf16x8, w1); }
            { const LAS unsigned char* vb = lds + OFF_V + buf * VBUF + q32 * VSTR + hi * 8;
#pragma unroll
              for (int x = 0; x < 2; ++x)
#pragma unroll
                for (int jj = 0; jj < 2; ++jj) {
                    const int ko = (32 * x + 16 * jj) * 2;
                    const u32x2 a_lo = *(const LAS u32x2*)(vb + ko), a_hi = *(const LAS u32x2*)(vb + ko + 16);
                    const u32x2 b_lo = *(const LAS u32x2*)(vb + 32 * VSTR + ko), b_hi = *(const LAS u32x2*)(vb + 32 * VSTR + ko + 16);
                    const bf16x8 va = __builtin_bit_cast(bf16x8, (u32x4){a_lo.x, a_lo.y, a_hi.x, a_hi.y});
                    const bf16x8 vb2 = __builtin_bit_cast(bf16x8, (u32x4){b_lo.x, b_lo.y, b_hi.x, b_hi.y});
                    o0 = __builtin_amdgcn_mfma_f32_32x32x16_bf16(va, pb[x][jj], o0, 0, 0, 0);
                    o1 = __builtin_amdgcn_mfma_f32_32x32x16_bf16(vb2, pb[x][jj], o1, 0, 0, 0); } }
            if (ktn < 256) ATT_STORE(buf ^ 1);
            __syncthreads();
            buf ^= 1; kt = ktn;
        }
        const float ltot = lrun + shflx(lrun, 32, lane);
        const float inv = 1.0f / ltot;
        bf16_t* op = O + qrow * 512 + h * 64 + 4 * hi;
#pragma unroll
        for (int i = 0; i < 4; ++i) {
            u32x2 w; w.x = cvt_pk_bf16(o0[4 * i] * inv, o0[4 * i + 1] * inv); w.y = cvt_pk_bf16(o0[4 * i + 2] * inv, o0[4 * i + 3] * inv);
            *(u32x2*)(op + 8 * i) = w;
            u32x2 w2; w2.x = cvt_pk_bf16(o1[4 * i] * inv, o1[4 * i + 1] * inv); w2.y = cvt_pk_bf16(o1[4 * i + 2] * inv, o1[4 * i + 3] * inv);
            *(u32x2*)(op + 32 + 8 * i) = w2; }
#undef ATT_LOAD
#undef ATT_STORE
    }
}
}

constexpr int NWAVES = 8, NTHR = 512;
constexpr int LDS_BYTES = 131072 + 1024;

typedef const Params __attribute__((address_space(4)))* KArg;
struct Ctx { int tid, lane, wave, G, c, gw, NGW; LAS unsigned char* lds; };

enum { I_X = 0, I_C, I_POS, I_WADA, I_BADA, I_N1G, I_WIN, I_AR, I_AI, I_LDT, I_BR, I_BI, I_CR, I_CI, I_SD, I_WGLU, I_BGLU, I_WAOUT, I_QNG, I_WUQ, I_KVNG, I_WUK, I_WUV, I_WBOUT, I_WOUT, I_N2G, I_WGATE, I_WUP, I_WDOWN, I_FING };

__device__ __forceinline__ void sincos_acc(double x, float& s, float& c) {
    const double rev = x * 0.15915494309189535; const double r = rev - __builtin_rint(rev);
    const float th = (float)(r * 6.283185307179586);
    s = sinf(th); c = cosf(th);
}
__device__ __forceinline__ float inv_freq_tab(int i) {
    switch (i) { case 0: return 1.0f; case 1: return 0.5623413324356079f; case 2: return 0.3162277638912201f; case 3: return 0.17782793939113617f; case 4: return 0.10000000149011612f;
    case 5: return 0.05623413249850273f; case 6: return 0.03162277489900589f; case 7: return 0.017782794311642647f; case 8: return 0.009999999776482582f; case 9: return 0.005623413249850273f;
    case 10: return 0.003162277629598975f; case 11: return 0.0017782794311642647f; case 12: return 0.0010000000474974513f; case 13: return 0.000562341301701963f; case 14: return 0.0003162277571391314f;
    default: return 0.00017782794020604342f; }
}
__device__ __forceinline__ void p0_mod(const Ctx& X, KArg P) {
    LAS float* sc = (LAS float*)X.lds;
    LAS float* red = sc + 2048;
    const float* cin = P->in[I_C];
    for (int i = X.tid; i < 2048; i += NTHR) { const float v = cin[i]; sc[i] = v * sigmoidf_(v); }
    __syncthreads();
    float* mod = (float*)(P->ws + WS_MOD);
    for (int unit = X.c; unit < DEPTH * 96; unit += X.G) {
        const int l = unit / 96, cb = unit % 96, kp = X.tid >> 6, cj = X.tid & 63, col = cb * 64 + cj;
        const float* w = P->in[I_WADA] + ((size_t)l * 1024 + kp * 128) * 6144 + col;
        float a0 = 0.f, a1 = 0.f;
#pragma unroll 8
        for (int k = 0; k < 128; ++k) { const float wv = w[(size_t)k * 6144]; a0 += sc[kp * 128 + k] * wv; a1 += sc[1024 + kp * 128 + k] * wv; }
        red[(kp * 64 + cj) * 2] = a0; red[(kp * 64 + cj) * 2 + 1] = a1;
        __syncthreads();
        if (X.tid < 128) { const int b = X.tid >> 6, cj2 = X.tid & 63; float s = 0.f;
#pragma unroll
            for (int q = 0; q < 8; ++q) s += red[(q * 64 + cj2) * 2 + b];
            mod[((size_t)l * 2 + b) * 6144 + cb * 64 + cj2] = s + P->in[I_BADA][(size_t)l * 6144 + cb * 64 + cj2]; }
        __syncthreads();
    }
}
__device__ __forceinline__ void p0_tables(const Ctx& X, KArg P) {
    const int* pos = (const int*)P->in[I_POS];
    float* cosT = (float*)(P->ws + WS_ROPE); float* sinT = cosT + (size_t)T * 16;
    for (int idx = X.c * NTHR + X.tid; idx < T * 16; idx += X.G * NTHR) {
        const int tok = idx >> 4, i = idx & 15;
        const float ang = (float)pos[tok] * inv_freq_tab(i);
        float s, c; sincos_acc((double)ang, s, c);
        cosT[idx] = c; sinT[idx] = s;
    }
    int* tmin = (int*)(P->ws + WS_TPOS); int* tmax = tmin + 512;
    for (int t = X.gw; t < 512; t += X.NGW) {
        int v = pos[t * 64 + X.lane], mn = v, mx = v;
#pragma unroll
        for (int o = 1; o < 64; o <<= 1) { mn = min(mn, shflxi(mn, o, X.lane)); mx = max(mx, shflxi(mx, o, X.lane)); }
        if (X.lane == 0) { tmin[t] = mn; tmax[t] = mx; }
    }
}
__device__ __forceinline__ void ssm_stage1(const Ctx& X, KArg P, int l) {
    const float* a_re = P->in[I_AR] + (size_t)l * NG * SP; const float* a_im = P->in[I_AI] + (size_t)l * NG * SP; const float* ldt = P->in[I_LDT] + (size_t)l * NG;
    f32x2* apow = (f32x2*)(P->ws + WS_APOW); f32x2* bbar = (f32x2*)(P->ws + WS_BBAR);
    for (int idx = X.c * NTHR + X.tid; idx < NG * 66 * 64; idx += X.G * NTHR) {
        const int g = idx / (66 * 64), j = (idx >> 6) % 66, p = idx & 63;
        const float n = (j == 65) ? 2048.0f : (float)j;
        const float dt = expf(ldt[g]), ar = a_re[g * 64 + p], ai = a_im[g * 64 + p];
        const float mag = expf(ar * dt * n); float s, c; sincos_acc((double)ai * (double)dt * (double)n, s, c);
        apow[idx] = (f32x2){mag * c, mag * s};
    }
    const float* b_re = P->in[I_BR] + (size_t)l * NG * SP * 16; const float* b_im = P->in[I_BI] + (size_t)l * NG * SP * 16;
    for (int idx = X.c * NTHR + X.tid; idx < NG * 64 * 16; idx += X.G * NTHR) {
        const int g = idx >> 10, p = (idx >> 4) & 63;
        const float dt = expf(ldt[g]), ar = a_re[g * 64 + p], ai = a_im[g * 64 + p];
        const float mag = expf(ar * dt); float s, c; sincos_acc((double)ai * (double)dt, s, c);
        const float nr = mag * c - 1.0f, ni = mag * s, den = ar * ar + ai * ai;
        const float cr = (nr * ar + ni * ai) / den, ci = (ni * ar - nr * ai) / den;
        const float br = b_re[idx], bi = b_im[idx];
        bbar[idx] = (f32x2){cr * br - ci * bi, cr * bi + ci * br};
    }
}
__device__ __forceinline__ void ssm_stage2(const Ctx& X, KArg P, int l) {
    const f32x2* apow = (const f32x2*)(P->ws + WS_APOW); const f32x2* bbar = (const f32x2*)(P->ws + WS_BBAR);
    const float* c_re = P->in[I_CR] + (size_t)l * NG * 16 * SP; const float* c_im = P->in[I_CI] + (size_t)l * NG * 16 * SP;
    bf16_t* Kg = (bf16_t*)(P->ws + WS_KG); bf16_t* Et = (bf16_t*)(P->ws + WS_ET); bf16_t* Ft = (bf16_t*)(P->ws + WS_FT);
    for (int idx = X.c * NTHR + X.tid; idx < NG * 128 * 256; idx += X.G * NTHR) {
        const int g = idx >> 15, jj = (idx >> 8) & 127, m = (idx >> 4) & 15, mp = idx & 15;
        float acc = 0.f;
        if (jj >= 64) { const int j = jj - 64;
            const float* cr = c_re + (g * 16 + m) * 64; const float* ci = c_im + (g * 16 + m) * 64; const f32x2* ap = apow + (g * 66 + j) * 64; const f32x2* bb = bbar + (size_t)g * 1024 + mp;
            for (int p = 0; p < 64; ++p) { const f32x2 a = ap[p], b2 = bb[p * 16]; const float wr = cr[p] * a.x - ci[p] * a.y, wi = cr[p] * a.y + ci[p] * a.x; acc += wr * b2.x - wi * b2.y; } }
        Kg[idx] = f2bf(acc);
    }
    for (int idx = X.c * NTHR + X.tid; idx < NG * 1024 * 128; idx += X.G * NTHR) {
        const int g = idx >> 17, n = (idx >> 7) & 1023, k = idx & 127, t = n >> 4, m = n & 15, p = k & 63;
        const f32x2 a = apow[(g * 66 + t + 1) * 64 + p]; const float cr = c_re[(g * 16 + m) * 64 + p], ci = c_im[(g * 16 + m) * 64 + p];
        const float wr = cr * a.x - ci * a.y, wi = cr * a.y + ci * a.x;
        Et[idx] = f2bf(k < 64 ? wr : -wi);
    }
    for (int idx = X.c * NTHR + X.tid; idx < NG * 128 * 1024; idx += X.G * NTHR) {
        const int g = idx >> 17, n = (idx >> 10) & 127, k = idx & 1023, s = k >> 4, mp = k & 15, p = n & 63;
        const f32x2 a = apow[(g * 66 + 63 - s) * 64 + p], b2 = bbar[(size_t)g * 1024 + p * 16 + mp];
        Ft[idx] = f2bf(n < 64 ? (a.x * b2.x - a.y * b2.y) : (a.x * b2.y + a.y * b2.x));
    }
}
struct SrcCol { const float* p; int ld; };
__device__ __forceinline__ SrcCol src_col(KArg P, int l, int mat, int n) {
    SrcCol r; r.p = nullptr; r.ld = 0;
    switch (mat) {
    case 0: { int s = -1; if (n < 896) s = n; else if (n < 928) { const int i = n - 896; s = 896 + (i >> 1) + (i & 1) * 16; } else if (n < 1024) s = -1; else if (n < 2048) s = 928 + (n - 1024); else s = 1952 + (n - 2048);
              r.ld = INC; if (s >= 0) r.p = P->in[I_WIN] + (size_t)l * 1024 * INC + s; } break;
    case 1: r.ld = 512; r.p = P->in[I_WGLU] + (size_t)l * 512 * 512 + n; break;
    case 2: r.ld = 1024; r.p = P->in[I_WAOUT] + (size_t)l * 512 * 1024 + n; break;
    case 3: r.ld = 1024; r.p = P->in[I_WBOUT] + (size_t)l * 512 * 1024 + n; break;
    case 4: { const int h = n / 96, d = n - h * 96; int s = n; if (d >= 64) { const int i = d - 64; s = h * 96 + 64 + (i >> 1) + (i & 1) * 16; }
              r.ld = 768; r.p = P->in[I_WUQ] + (size_t)l * 256 * 768 + s; } break;
    case 5: r.ld = 512; r.p = P->in[I_WUK] + (size_t)l * 128 * 512 + n; break;
    case 6: r.ld = 512; r.p = P->in[I_WUV] + (size_t)l * 128 * 512 + n; break;
    case 7: r.ld = 1024; r.p = P->in[I_WOUT] + (size_t)l * 1024 * 1024 + n; break;
    case 8: { const int g8 = n >> 3, q = n & 7; r.ld = DFF; r.p = (q < 4 ? P->in[I_WGATE] + (size_t)l * 1024 * DFF + 4 * g8 + q : P->in[I_WUP] + (size_t)l * 1024 * DFF + 4 * g8 + (q - 4)); } break;
    default: r.ld = 1024; r.p = P->in[I_WDOWN] + (size_t)l * DFF * 1024 + n; break;
    }
    return r;
}
template <int MAT, int K, int N>
__device__ __forceinline__ void weights_mat(const Ctx& X, KArg P, int l, bf16_t* Wdst, LAS float* scr, int base) {
    constexpr int nblk = N / 32, items = (K / 64) * nblk;
    const int first = ((X.gw - base) % X.NGW + X.NGW) % X.NGW;
    for (int it = first; it < items; it += X.NGW) {
        const int kb = it / nblk, nb = it % nblk, k0 = 64 * kb, n0 = 32 * nb;
        const SrcCol sc = src_col(P, l, MAT, n0 + (X.lane & 31));
#pragma unroll 8
        for (int i = 0; i < 32; ++i) { const int kk = 2 * i + (X.lane >> 5); scr[kk * 33 + (X.lane & 31)] = sc.p ? sc.p[(size_t)(k0 + kk) * sc.ld] : 0.f; }
        asm volatile("s_waitcnt lgkmcnt(0)" ::: "memory");
        const int ck = X.lane & 7;
#pragma unroll
        for (int j = 0; j < 4; ++j) { const int n = (X.lane >> 3) + 8 * j; const LAS float* s = scr + (8 * ck) * 33 + n;
            u32x4 o; o.x = cvt_pk_bf16(s[0], s[33]); o.y = cvt_pk_bf16(s[2 * 33], s[3 * 33]); o.z = cvt_pk_bf16(s[4 * 33], s[5 * 33]); o.w = cvt_pk_bf16(s[6 * 33], s[7 * 33]);
            *(u32x4*)(Wdst + (size_t)(n0 + n) * K + k0 + 8 * ck) = o; }
        asm volatile("s_waitcnt lgkmcnt(0)" ::: "memory");
    }
}
__device__ __forceinline__ void weights_phase(const Ctx& X, KArg P, int l) {
    bf16_t* W = (bf16_t*)(P->ws + WS_W);
    LAS float* scr = (LAS float*)(X.lds + X.wave * 8448);
    constexpr int I0 = 16 * 96, I1 = 8 * 16, I2 = 8 * 32, I3 = 8 * 32, I4 = 4 * 24, I5 = 2 * 16, I6 = 2 * 16, I7 = 16 * 32, I8 = 16 * 176;
    weights_mat<0, 1024, 3072>(X, P, l, W + WO_IN, scr, 0);
    weights_mat<1, 512, 512>(X, P, l, W + WO_GLU, scr, I0);
    weights_mat<2, 512, 1024>(X, P, l, W + WO_A, scr, I0 + I1);
    weights_mat<3, 512, 1024>(X, P, l, W + WO_B, scr, I0 + I1 + I2);
    weights_mat<4, 256, 768>(X, P, l, W + WO_UQ, scr, I0 + I1 + I2 + I3);
    weights_mat<5, 128, 512>(X, P, l, W + WO_UK, scr, I0 + I1 + I2 + I3 + I4);
    weights_mat<6, 128, 512>(X, P, l, W + WO_UV, scr, I0 + I1 + I2 + I3 + I4 + I5);
    weights_mat<7, 1024, 1024>(X, P, l, W + WO_OUT, scr, I0 + I1 + I2 + I3 + I4 + I5 + I6);
    weights_mat<8, 1024, 5632>(X, P, l, W + WO_GU, scr, I0 + I1 + I2 + I3 + I4 + I5 + I6 + I7);
    weights_mat<9, DFF, 1024>(X, P, l, W + WO_DOWN, scr, I0 + I1 + I2 + I3 + I4 + I5 + I6 + I7 + I8);
}
__device__ __forceinline__ void norm_phase(const Ctx& X, const float* x, const float* gain, const float* mod_sh, const float* mod_sc, bf16_t* h) {
    for (int row = X.gw; row < T; row += X.NGW) {
        const f32x4* xr = (const f32x4*)(x + (size_t)row * 1024) + X.lane;
        f32x4 v[4]; float ss = 0.f;
#pragma unroll
        for (int j = 0; j < 4; ++j) { v[j] = xr[64 * j]; ss += (v[j][0] * v[j][0] + v[j][1] * v[j][1]) + (v[j][2] * v[j][2] + v[j][3] * v[j][3]); }
        const float r = rsqrtf(wave_sum(ss, X.lane) * (1.0f / 1024.0f) + EPS);
        const int bo = row >= SEQ ? 6144 : 0;
#pragma unroll
        for (int j = 0; j < 4; ++j) { const int col = 256 * j + 4 * X.lane;
            const f32x4 g4 = *(const f32x4*)(gain + col), s4 = *(const f32x4*)(mod_sc + bo + col), h4 = *(const f32x4*)(mod_sh + bo + col);
            const f32x4 o = v[j] * r * g4 * (s4 + 1.0f) + h4;
            u32x2 w; w.x = cvt_pk_bf16(o[0], o[1]); w.y = cvt_pk_bf16(o[2], o[3]);
            *(u32x2*)(h + (size_t)row * 1024 + col) = w; }
    }
}
__device__ __forceinline__ void final_norm_phase(const Ctx& X, float* x, const float* gain) {
    for (int row = X.gw; row < T; row += X.NGW) {
        f32x4* xr = (f32x4*)(x + (size_t)row * 1024) + X.lane;
        f32x4 v[4]; float ss = 0.f;
#pragma unroll
        for (int j = 0; j < 4; ++j) { v[j] = xr[64 * j]; ss += (v[j][0] * v[j][0] + v[j][1] * v[j][1]) + (v[j][2] * v[j][2] + v[j][3] * v[j][3]); }
        const float r = rsqrtf(wave_sum(ss, X.lane) * (1.0f / 1024.0f) + EPS);
#pragma unroll
        for (int j = 0; j < 4; ++j) { const f32x4 g4 = *(const f32x4*)(gain + 256 * j + 4 * X.lane); xr[64 * j] = v[j] * r * g4; }
    }
}
__device__ __forceinline__ void prep_phase(const Ctx& X, KArg P, int l) {
    bf16_t* zx = (bf16_t*)(P->ws + WS_ZX); bf16_t* Kpe = (bf16_t*)(P->ws + WS_KPE);
    const float* cosT = (const float*)(P->ws + WS_ROPE); const float* sinT = cosT + (size_t)T * 16;
    const float* qg = P->in[I_QNG] + (size_t)l * QL; const float* kg = P->in[I_KVNG] + (size_t)l * KVL;
    for (int row = X.gw; row < T; row += X.NGW) {
        bf16_t* zr = zx + (size_t)row * 512;
        const u32x2 cq = *(const u32x2*)(zr + 4 * X.lane); const unsigned ck = *(const unsigned*)(zr + 256 + 2 * X.lane);
        const float q0 = bflo(cq.x), q1 = bfhi(cq.x), q2 = bflo(cq.y), q3 = bfhi(cq.y), k0 = bflo(ck), k1 = bfhi(ck);
        const float rq = rsqrtf(wave_sum((q0 * q0 + q1 * q1) + (q2 * q2 + q3 * q3), X.lane) * (1.0f / 256.0f) + EPS);
        const float rk = rsqrtf(wave_sum(k0 * k0 + k1 * k1, X.lane) * (1.0f / 128.0f) + EPS);
        const f32x4 g4 = *(const f32x4*)(qg + 4 * X.lane); const f32x2 g2 = *(const f32x2*)(kg + 2 * X.lane);
        u32x2 wq; wq.x = cvt_pk_bf16(q0 * rq * g4[0], q1 * rq * g4[1]); wq.y = cvt_pk_bf16(q2 * rq * g4[2], q3 * rq * g4[3]);
        const unsigned wk = cvt_pk_bf16(k0 * rk * g2[0], k1 * rk * g2[1]);
        if (X.lane < 16) { const unsigned kr = *(const unsigned*)(zr + 384 + 2 * X.lane); const float x1 = bflo(kr), x2 = bfhi(kr);
            const float c = cosT[(size_t)row * 16 + X.lane], s = sinT[(size_t)row * 16 + X.lane];
            *(unsigned*)(Kpe + (size_t)row * 32 + 2 * X.lane) = cvt_pk_bf16(x1 * c - x2 * s, x2 * c + x1 * s); }
        *(u32x2*)(zr + 4 * X.lane) = wq; *(unsigned*)(zr + 256 + 2 * X.lane) = wk;
    }
}
__device__ __forceinline__ void carry_phase(const Ctx& X, KArg P) {
    const float* S = (const float*)(P->ws + WS_S); bf16_t* Hc = (bf16_t*)(P->ws + WS_HC); const f32x2* apow = (const f32x2*)(P->ws + WS_APOW);
    LAS f32x2* Ew = (LAS f32x2*)X.lds;
    for (int i = X.c; i < 64; i += X.G) {
        const int b = i >> 5, g = i & 31, p = X.lane, w = X.wave;
        const f32x2 a64 = apow[(g * 66 + 64) * 64 + p], a2k = apow[(g * 66 + 65) * 64 + p];
        const size_t r0 = ((size_t)g * NCH + b * 256 + w * 32) * 128;
        float hr = 0.f, hi = 0.f;
#pragma unroll 8
        for (int cc = 0; cc < 32; ++cc) { const float sr = S[r0 + cc * 128 + p], si = S[r0 + cc * 128 + 64 + p];
            const float nr = a64.x * hr - a64.y * hi + sr, ni = a64.x * hi + a64.y * hr + si; hr = nr; hi = ni; }
        Ew[w * 64 + p] = (f32x2){hr, hi};
        __syncthreads();
        hr = 0.f; hi = 0.f;
        for (int q = 0; q < w; ++q) { const f32x2 e = Ew[q * 64 + p]; const float nr = a2k.x * hr - a2k.y * hi + e.x, ni = a2k.x * hi + a2k.y * hr + e.y; hr = nr; hi = ni; }
#pragma unroll 8
        for (int cc = 0; cc < 32; ++cc) { const float sr = S[r0 + cc * 128 + p], si = S[r0 + cc * 128 + 64 + p];
            Hc[r0 + cc * 128 + p] = f2bf(hr); Hc[r0 + cc * 128 + 64 + p] = f2bf(hi);
            const float nr = a64.x * hr - a64.y * hi + sr, ni = a64.x * hi + a64.y * hr + si; hr = nr; hi = ni; }
        __syncthreads();
    }
}

#ifndef PHMASK
#define PHMASK 0xffffffffu
#endif
__global__ void __launch_bounds__(NTHR, 2) trunk_fwd(Params Pval) {
    extern __shared__ __attribute__((aligned(16))) unsigned char lds_raw[];
    cg::grid_group grid = cg::this_grid();
    Ctx X; X.lds = (LAS unsigned char*)lds_raw; X.tid = threadIdx.x; X.lane = X.tid & 63; X.wave = __builtin_amdgcn_readfirstlane(X.tid >> 6);
    X.G = gridDim.x; X.c = blockIdx.x; X.gw = X.c * NWAVES + X.wave; X.NGW = X.G * NWAVES;
    using pg8::Gemm; using pg8::Order;
    KArg P = (KArg)__builtin_amdgcn_kernarg_segment_ptr();
    unsigned char* ws;
    unsigned bar_epoch = 0;
    unsigned* const bar_word = (unsigned*)(P->ws + WS_BAR);
#define GRID_SYNC() do { __builtin_amdgcn_fence(__ATOMIC_RELEASE, "agent"); asm volatile("s_waitcnt vmcnt(0)" ::: "memory"); __syncthreads(); bar_epoch += 1; \
        if (threadIdx.x == 0) { __hip_atomic_fetch_add(bar_word, 1u, __ATOMIC_RELAXED, __HIP_MEMORY_SCOPE_AGENT); \
            while (__hip_atomic_load(bar_word, __ATOMIC_RELAXED, __HIP_MEMORY_SCOPE_AGENT) < bar_epoch * (unsigned)X.G) __builtin_amdgcn_s_sleep(2); } \
        __syncthreads(); __builtin_amdgcn_fence(__ATOMIC_ACQUIRE, "agent"); asm volatile("s_waitcnt vmcnt(0)" ::: "memory"); } while (0)
#define FRESH() do { asm volatile("" : "+s"(P)); asm volatile("" : "+v"(X.tid), "+v"(X.lane)); ws = P->ws; } while (0)
#define mod ((float*)(ws + WS_MOD))
#define cosT ((const float*)(ws + WS_ROPE))
#define sinT (cosT + (size_t)T * 16)
#define tmin ((const int*)(ws + WS_TPOS))
#define tmax (tmin + 512)
#define Wb ((bf16_t*)(ws + WS_W))
#define Hb ((bf16_t*)(ws + WS_H))
#define Ug ((bf16_t*)(ws + WS_UG))
#define zx ((bf16_t*)(ws + WS_ZX))
#define gates ((bf16_t*)(ws + WS_GATES))
#define Qb ((bf16_t*)(ws + WS_Q))
#define Kn ((bf16_t*)(ws + WS_KN))
#define Kpe ((bf16_t*)(ws + WS_KPE))
#define Vt ((bf16_t*)(ws + WS_VT))
#define Ob ((bf16_t*)(ws + WS_O))
#define ypart ((bf16_t*)(ws + WS_YPART))
#define ya ((bf16_t*)(ws + WS_YA))
#define yg ((bf16_t*)(ws + WS_YG))
#define hid ((bf16_t*)(ws + WS_HID))
#define Sb ((float*)(ws + WS_S))
#define Hc ((bf16_t*)(ws + WS_HC))
#define modl (mod + (size_t)l * 2 * 6144)
#define xin ((l == 0) ? P->in[I_X] : (const float*)P->out)

#define PH(n) if (PHMASK & (1u << (n)))
    grid.sync();
    PH(0) { FRESH(); p0_mod(X, P); p0_tables(X, P); }
    GRID_SYNC();

    for (int l = 0; l < DEPTH; ++l) {
        PH(1) { FRESH(); weights_phase(X, P, l); ssm_stage1(X, P, l); }
        PH(2) { FRESH(); norm_phase(X, xin, P->in[I_N1G] + (size_t)l * 1024, modl + 0, modl + 1024, Hb); }
        GRID_SYNC();
        PH(3) { FRESH(); ssm_stage2(X, P, l); }
        PH(4) { FRESH(); Gemm g{Hb, Wb + WO_IN, 1024, 1024, 0, 0, 1024}; Order S; S.init(T, 3072, 1, X.G, X.c); pg8::EpiIn E{Ug, zx, gates};
          pg8::gemm_phase<pg8::EpiIn, false>(X.lds, g, S, E); }
        GRID_SYNC();
        PH(5) { FRESH(); prep_phase(X, P, l); }
        PH(6) { FRESH(); Gemm g{Ug, (const bf16_t*)(ws + WS_FT), 1024, 1024, (size_t)NCH * 1024, (size_t)128 * 1024, 1024}; Order S; S.init(NCH, 256, NG, X.G, X.c); pg8::EpiS E{Sb};
          pg8::gemm_phase<pg8::EpiS, false>(X.lds, g, S, E); }
        GRID_SYNC();
        PH(7) { FRESH(); carry_phase(X, P); }
        PH(8) { FRESH(); Gemm g{zx, Wb + WO_UQ, 512, 256, 0, 0, 256}; Order S; S.init(T, 768, 1, X.G, X.c); pg8::EpiQ E{Qb, cosT, sinT, 0.10206207261596577f * 1.4426950408889634f};
          pg8::gemm_phase<pg8::EpiQ, false>(X.lds, g, S, E); }
        PH(9) { FRESH(); Gemm g{zx + 256, Wb + WO_UK, 512, 128, 0, 0, 128}; Order S; S.init(T, 512, 1, X.G, X.c); pg8::EpiStore E{Kn, 0, 512};
          pg8::gemm_phase<pg8::EpiStore, false>(X.lds, g, S, E); }
        PH(10) { FRESH(); Gemm g{Wb + WO_UV, zx + 256, 128, 512, 0, 0, 128}; Order S; S.init(512, T, 1, X.G, X.c); pg8::EpiStore E{Vt, 0, T};
          pg8::gemm_phase<pg8::EpiStore, false>(X.lds, g, S, E); }
        GRID_SYNC();
#ifdef ATT_DUMMY
        PH(11) { FRESH(); for (int idx = X.c * NTHR + X.tid; idx < T * 512; idx += X.G * NTHR) { const int row = idx >> 9, cc = idx & 511, h = cc >> 6, d = cc & 63;
            const float v = bf2f(Qb[(size_t)row * 768 + h * 96 + d]) + bf2f(Qb[(size_t)row * 768 + h * 96 + 64 + (d & 31)]) + bf2f(Kn[(size_t)row * 512 + cc]) + bf2f(Vt[(size_t)cc * T + row]) + bf2f(Kpe[(size_t)row * 32 + (d & 31)]);
            Ob[idx] = f2bf(v * 0.25f); } }
#else
        PH(11) { FRESH(); att::phase(X.lds, Qb, Kn, Kpe, Vt, Ob, (const int*)P->in[I_POS], tmin, tmax, X.G, X.c); }
#endif
#ifdef SYNC_AFTER_ATT
        GRID_SYNC();
#endif
        PH(12) { FRESH(); Gemm g{Ug, (const bf16_t*)(ws + WS_KG) + 16384, 1024, 16, (size_t)NCH * 1024, 32768, 1024}; Order S; S.init(NCH, 1024, NG, X.G, X.c); pg8::EpiStore E{ypart, (size_t)NCH * 1024, 1024};
          pg8::gemm_phase<pg8::EpiStore, true>(X.lds, g, S, E); }
        PH(13) { FRESH(); Gemm g{Hc, (const bf16_t*)(ws + WS_ET), 128, 128, (size_t)NCH * 128, (size_t)1024 * 128, 128}; Order S; S.init(NCH, 1024, NG, X.G, X.c);
          pg8::EpiE E{ypart, Ug, P->in[I_SD] + (size_t)l * SW, ya};
          pg8::gemm_phase<pg8::EpiE, false>(X.lds, g, S, E); }
        GRID_SYNC();
        PH(14) { FRESH(); Gemm g{ya, Wb + WO_GLU, 512, 512, 0, 0, 512}; Order S; S.init(T, 512, 1, X.G, X.c); pg8::EpiGlu E{ya, P->in[I_BGLU] + (size_t)l * SW, yg};
          pg8::gemm_phase<pg8::EpiGlu, false>(X.lds, g, S, E); }
        GRID_SYNC();
        PH(15) { FRESH(); Gemm g{yg, Wb + WO_A, 512, 512, 0, 0, 512}; Order S; S.init(T, 1024, 1, X.G, X.c); pg8::EpiMerge<false> E{gates, 0, Hb};
          pg8::gemm_phase<pg8::EpiMerge<false>, false>(X.lds, g, S, E); }
        PH(16) { FRESH(); Gemm g{Ob, Wb + WO_B, 512, 512, 0, 0, 512}; Order S; S.init(T, 1024, 1, X.G, X.c); pg8::EpiMerge<true> E{gates, 1024, Hb};
          pg8::gemm_phase<pg8::EpiMerge<true>, false>(X.lds, g, S, E); }
        GRID_SYNC();
        PH(17) { FRESH(); Gemm g{Hb, Wb + WO_OUT, 1024, 1024, 0, 0, 1024}; Order S; S.init(T, 1024, 1, X.G, X.c); pg8::EpiRes E{xin, P->out, modl + 2048};
          pg8::gemm_phase<pg8::EpiRes, false>(X.lds, g, S, E); }
        GRID_SYNC();
        PH(18) { FRESH(); norm_phase(X, P->out, P->in[I_N2G] + (size_t)l * 1024, modl + 3072, modl + 4096, Hb); }
        GRID_SYNC();
        PH(19) { FRESH(); Gemm g{Hb, Wb + WO_GU, 1024, 1024, 0, 0, 1024}; Order S; S.init(T, 5632, 1, X.G, X.c); pg8::EpiGU E{hid};
          pg8::gemm_phase<pg8::EpiGU, false>(X.lds, g, S, E); }
        GRID_SYNC();
        PH(20) { FRESH(); Gemm g{hid, Wb + WO_DOWN, DFF, DFF, 0, 0, DFF}; Order S; S.init(T, 1024, 1, X.G, X.c); pg8::EpiRes E{P->out, P->out, modl + 5120};
          pg8::gemm_phase<pg8::EpiRes, false>(X.lds, g, S, E); }
        GRID_SYNC();
    }
    PH(21) { FRESH(); final_norm_phase(X, P->out, P->in[I_FING]); }
}

extern "C" void kernel_launch(void* const* d_in, const int* in_sizes, int n_in, void* d_out, int out_size, void* d_ws, size_t ws_size, hipStream_t stream) {
    static int grid_blocks = 0;
    if (grid_blocks == 0) {
        if (n_in != 30 || ws_size < WS_END) { fprintf(stderr, "kernel_launch: unexpected n_in %d / ws_size %zu (need %zu)\n", n_in, ws_size, (size_t)WS_END); grid_blocks = -1; return; }
        int dev = 0, cus = 0, per_cu = 0;
        hipGetDevice(&dev);
        hipDeviceGetAttribute(&cus, hipDeviceAttributeMultiprocessorCount, dev);
        if (hipFuncSetAttribute((const void*)trunk_fwd, hipFuncAttributeMaxDynamicSharedMemorySize, LDS_BYTES) != hipSuccess) fprintf(stderr, "kernel_launch: hipFuncSetAttribute failed\n");
        hipOccupancyMaxActiveBlocksPerMultiprocessor(&per_cu, (const void*)trunk_fwd, NTHR, LDS_BYTES);
        if (per_cu < 1) per_cu = 1;
        grid_blocks = cus * per_cu;
        fprintf(stderr, "kernel_launch: cus %d per_cu %d grid %d\n", cus, per_cu, grid_blocks);
    }
    if (grid_blocks < 0) return;
    if (hipMemsetAsync((char*)d_ws + WS_BAR, 0, 256, stream) != hipSuccess) fprintf(stderr, "kernel_launch: memset failed\n");
    Params p{};
    for (int i = 0; i < 30; ++i) p.in[i] = (const float*)d_in[i];
    p.out = (float*)d_out; p.ws = (unsigned char*)d_ws;
    void* args[] = {&p};
    hipError_t e = hipLaunchCooperativeKernel((const void*)trunk_fwd, dim3(grid_blocks), dim3(NTHR), args, LDS_BYTES, stream);
    if (e != hipSuccess) fprintf(stderr, "cooperative launch failed: %s (grid %d)\n", hipGetErrorString(e), grid_blocks);
}
```

```cpp
#include <hip/hip_runtime.h>
#include <hip/hip_cooperative_groups.h>
#include <cstdio>
#include <cstdint>
#include <cstddef>
namespace cg = cooperative_groups;

#define LAS __attribute__((address_space(3)))
typedef unsigned short bf16_t;
typedef short bf16x8 __attribute__((ext_vector_type(8)));
typedef short s16x4 __attribute__((ext_vector_type(4)));
typedef float f32x4 __attribute__((ext_vector_type(4)));
typedef float f32x2 __attribute__((ext_vector_type(2)));
typedef float f32x16 __attribute__((ext_vector_type(16)));
typedef unsigned u32x4 __attribute__((ext_vector_type(4)));
typedef unsigned u32x2 __attribute__((ext_vector_type(2)));
typedef int i32x4 __attribute__((ext_vector_type(4)));

constexpr int D = 1024, BATCH = 2, SEQ = 16384, T = BATCH * SEQ, DEPTH = 4;
constexpr int SW = 512, NG = 32, SP = 64;
constexpr int NH = 8, QKD = 96, QL = 256, KVL = 128;
constexpr int DFF = 2816, INC = 2976;
constexpr int NCH = T / 64;
constexpr float EPS = 1e-6f;

constexpr size_t MiB = 1u << 20;
constexpr size_t WS_MOD = 0, WS_TPOS = 1 * MiB, WS_ROPE = 2 * MiB, WS_APOW = 6 * MiB, WS_BBAR = 8 * MiB, WS_KG = 9 * MiB, WS_ET = 11 * MiB, WS_FT = 19 * MiB,
                 WS_S = 28 * MiB, WS_HC = 36 * MiB, WS_W = 40 * MiB, WS_H = 68 * MiB, WS_UG = 132 * MiB, WS_ZX = 164 * MiB, WS_GATES = 196 * MiB, WS_Q = 324 * MiB,
                 WS_KN = 372 * MiB, WS_KPE = 404 * MiB, WS_VT = 406 * MiB, WS_O = 438 * MiB, WS_YPART = 470 * MiB, WS_END = 502 * MiB;
constexpr size_t WS_BAR = 1 * MiB + 65536;
constexpr size_t WS_YA = WS_ZX, WS_YG = WS_Q, WS_HID = WS_GATES;
constexpr size_t WO_IN = 0, WO_GLU = WO_IN + 3072 * 1024, WO_A = WO_GLU + 512 * 512, WO_B = WO_A + 1024 * 512, WO_UQ = WO_B + 1024 * 512, WO_UK = WO_UQ + 768 * 256,
                 WO_UV = WO_UK + 512 * 128, WO_OUT = WO_UV + 512 * 128, WO_GU = WO_OUT + 1024 * 1024, WO_DOWN = WO_GU + 5632 * 1024, WO_END = WO_DOWN + 1024 * 2816;
static_assert(WO_END * 2 <= 28 * MiB, "weight region");

struct Params {
    const float* in[30];
    float* out;
    unsigned char* ws;
};

typedef __bf16 bf16x2_t __attribute__((ext_vector_type(2)));
__device__ __forceinline__ unsigned cvt_pk_bf16(float lo, float hi) { f32x2 v = {lo, hi}; bf16x2_t b = __builtin_convertvector(v, bf16x2_t); return __builtin_bit_cast(unsigned, b); }
__device__ __forceinline__ bf16_t f2bf(float f) { unsigned u = __builtin_bit_cast(unsigned, f); return (bf16_t)((u + 0x7fffu + ((u >> 16) & 1u)) >> 16); }
__device__ __forceinline__ float bf2f(unsigned short h) { return __builtin_bit_cast(float, (unsigned)h << 16); }
__device__ __forceinline__ float bflo(unsigned w) { return __builtin_bit_cast(float, w << 16); }
__device__ __forceinline__ float bfhi(unsigned w) { return __builtin_bit_cast(float, w & 0xffff0000u); }
__device__ __forceinline__ float sigmoidf_(float x) { return __builtin_amdgcn_rcpf(1.0f + __expf(-x)); }
__device__ __forceinline__ float gelu_tanh(float x) { const float z = 1.5957691216f * (x + 0.044715f * x * x * x); return x * sigmoidf_(z); }
__device__ __forceinline__ u32x4 pack8(const f32x4 a, const f32x4 b) { u32x4 w; w.x = cvt_pk_bf16(a[0], a[1]); w.y = cvt_pk_bf16(a[2], a[3]); w.z = cvt_pk_bf16(b[0], b[1]); w.w = cvt_pk_bf16(b[2], b[3]); return w; }
__device__ __forceinline__ void unpack8(const u32x4 w, f32x4& a, f32x4& b) { a = (f32x4){bflo(w.x), bfhi(w.x), bflo(w.y), bfhi(w.y)}; b = (f32x4){bflo(w.z), bfhi(w.z), bflo(w.w), bfhi(w.w)}; }
__device__ __forceinline__ float shflx(float v, int o, int lane) { return __builtin_bit_cast(float, __builtin_amdgcn_ds_bpermute((lane ^ o) << 2, __builtin_bit_cast(int, v))); }
__device__ __forceinline__ int shflxi(int v, int o, int lane) { return __builtin_amdgcn_ds_bpermute((lane ^ o) << 2, v); }
__device__ __forceinline__ float wave_sum(float v, int lane) {
#pragma unroll
    for (int o = 1; o < 64; o <<= 1) v += shflx(v, o, lane);
    return v;
}

namespace pg8 {
constexpr int BM = 256, BK = 64, HALF = 128, HTB = HALF * BK * 2, STAGE_BYTES = 8 * HTB, NXCD = 8, WGM = 8;
__device__ __forceinline__ int lds_byte(int r, int c) { const int st = (r >> 4) * 2 + (c >> 5), rr = r & 15, cc = c & 31, ob = rr * 64 + cc * 2; return st * 1024 + (ob ^ (((ob >> 9) & 1) << 5)); }
__device__ __forceinline__ void stage_rc(int b, int& R, int& C) { const int st = b / 1024, sb = b % 1024, swz = sb ^ (((sb >> 9) & 1) << 5); R = (st >> 1) * 16 + swz / 64; C = (st & 1) * 32 + (swz % 64) / 2; }
__device__ __forceinline__ int perm32(int rho) { const int n = rho >> 4, i = rho & 15; return 8 * (i >> 2) + 4 * n + (i & 3); }

struct Unit { int g, pm, pn; };
struct Gemm { const bf16_t* A; const bf16_t* Bt; int lda, ldb; size_t gsA, gsB; int K; };

struct Order {
    int nM, nN, per, total, G, c;
    __device__ void init(int M, int N, int groups, int G_, int c_) { nM = M / BM; nN = N / BM; per = nM * nN; total = per * groups; G = G_; c = c_; }
    __device__ bool next(int i, Unit& u) const {
        const int L = i * G + c; if (L >= total) return false;
        const int grp = L / per; int wgid = L - grp * per;
        { const int q = per / NXCD, r = per % NXCD, xcd = wgid % NXCD, off = wgid / NXCD; wgid = (xcd < r ? xcd * (q + 1) : r * (q + 1) + (xcd - r) * q) + off; }
        const int nig = WGM * nN, gid = wgid / nig, fm = gid * WGM, gsz = (nM - fm) < WGM ? (nM - fm) : WGM;
        u.g = grp; u.pm = fm + ((wgid % nig) % gsz); u.pn = (wgid % nig) / gsz; return true;
    }
};

template <class Epi, bool TOEP>
__device__ __forceinline__ void gemm_phase(LAS unsigned char* lds, const Gemm g, const Order& S, const Epi& E, int tid_in) {
    int tid_ = tid_in; asm volatile("" : "+v"(tid_));
    const int tid = tid_, wid = __builtin_amdgcn_readfirstlane(tid >> 6), lane = tid & 63, wr = wid >> 2, wc = wid & 3, fr = lane & 15, fq = lane >> 4;
    const int K = g.K, nt = K / BK;
    unsigned voffA[2], voffB[2];
#pragma unroll
    for (int i = 0; i < 2; ++i) { int R, C; stage_rc(tid * 16 + i * 8192, R, C); const int Rb = (R & ~31) + perm32(R & 31);
        voffA[i] = (unsigned)(R * g.lda + C) * 2u; voffB[i] = TOEP ? (unsigned)(Rb * g.ldb + (C & 15) - (C >> 4) * 256 + 768) * 2u : (unsigned)(Rb * g.ldb + C) * 2u; }
    const ptrdiff_t kstepA = (ptrdiff_t)(BK * 2), kstepB = TOEP ? (ptrdiff_t)-2048 : (ptrdiff_t)(BK * 2);
    const ptrdiff_t hstepA = (ptrdiff_t)HALF * g.lda * 2, hstepB = (ptrdiff_t)HALF * g.ldb * 2;
    const unsigned ldsb = (unsigned)(size_t)lds + (unsigned)wid * 1024u;
    const int aoff = lds_byte(wr * 64 + fr, fq * 8), boff = lds_byte(wc * 32 + fr, fq * 8);
#define PG8_UA(u) ((const char*)g.A + ((size_t)(u).g * g.gsA + (size_t)(u).pm * BM * g.lda) * 2)
#define PG8_UB(u) ((const char*)g.Bt + ((size_t)(u).g * g.gsB + (size_t)(u).pn * BM * g.ldb) * 2 - (TOEP ? 1536 : 0))
#define PG8_SA(b, h) (((b) * 2 + (h)) * HTB)
#define PG8_SB(b, h) ((4 + (b) * 2 + (h)) * HTB)
#define PG8_STAGE(bufoff, gbase, voff) do { _Pragma("unroll") for (int _i = 0; _i < 2; ++_i) { unsigned keep_; \
        asm volatile("s_mov_b32 %0, m0\n\ts_mov_b32 m0, %3\n\ts_nop 0\n\tglobal_load_lds_dwordx4 %1, %2\n\ts_mov_b32 m0, %0" : "=&s"(keep_) : "v"((voff)[_i]), "s"((const char*)(gbase)), "s"(ldsb + (unsigned)((bufoff) + _i * 8192)) : "memory"); } } while (0)
#define PG8_LDA(dst, b, h) do { _Pragma("unroll") for (int m = 0; m < 4; ++m) _Pragma("unroll") for (int k = 0; k < 2; ++k) dst[m][k] = *(const LAS bf16x8*)(lds + PG8_SA(b, h) + aoff + m * 2048 + k * 1024); } while (0)
#define PG8_LDB(dst, b, h) do { _Pragma("unroll") for (int n = 0; n < 2; ++n) _Pragma("unroll") for (int k = 0; k < 2; ++k) dst[n][k] = *(const LAS bf16x8*)(lds + PG8_SB(b, h) + boff + n * 2048 + k * 1024); } while (0)
#define PG8_MMA(ai, bj, At, Bt) do { __builtin_amdgcn_s_setprio(1); _Pragma("unroll") for (int m = 0; m < 4; ++m) _Pragma("unroll") for (int n = 0; n < 2; ++n) _Pragma("unroll") for (int k = 0; k < 2; ++k) \
        acc[ai][bj][m][n] = __builtin_amdgcn_mfma_f32_16x16x32_bf16(Bt[n][k], At[m][k], acc[ai][bj][m][n], 0, 0, 0); __builtin_amdgcn_s_setprio(0); } while (0)
#define PG8_WAIT_V(n) asm volatile("s_waitcnt vmcnt(" #n ")" ::: "memory")
#define PG8_WAIT_L(n) asm volatile("s_waitcnt lgkmcnt(" #n ")" ::: "memory")
#define PG8_BAR __builtin_amdgcn_s_barrier()
#define PG8_SCHED __builtin_amdgcn_sched_barrier(0)
    Unit cur, nxt; int ui = 0;
    if (!S.next(0, cur)) return;
    f32x4 acc[2][2][4][2];
#pragma unroll
    for (int a = 0; a < 2; ++a)
#pragma unroll
        for (int b = 0; b < 2; ++b)
#pragma unroll
            for (int m = 0; m < 4; ++m)
#pragma unroll
                for (int n = 0; n < 2; ++n) acc[a][b][m][n] = (f32x4){0.f, 0.f, 0.f, 0.f};
    bf16x8 At[4][2], B0[2][2], B1[2][2];
    const char* cA = PG8_UA(cur); const char* cB = PG8_UB(cur);
    PG8_STAGE(PG8_SB(0, 0), cB, voffB); PG8_STAGE(PG8_SB(0, 1), cB + hstepB, voffB); PG8_STAGE(PG8_SA(0, 0), cA, voffA); PG8_STAGE(PG8_SA(0, 1), cA + hstepA, voffA);
    if (wr == 1) PG8_BAR;
    PG8_WAIT_V(2); PG8_BAR;
    PG8_STAGE(PG8_SB(1, 0), cB + kstepB, voffB); PG8_STAGE(PG8_SA(1, 0), cA + kstepA, voffA); PG8_STAGE(PG8_SB(1, 1), cB + hstepB + kstepB, voffB);
    PG8_WAIT_V(6); PG8_BAR;
    for (;;) {
        const bool has_next = S.next(ui + 1, nxt);
        const char* nA = has_next ? PG8_UA(nxt) : cA; const char* nB = has_next ? PG8_UB(nxt) : cB;
        for (int t = 0; t < nt; t += 2) {
            const bool last = (t == nt - 2);
            asm volatile("" : "+v"(voffA[0]), "+v"(voffA[1]), "+v"(voffB[0]), "+v"(voffB[1]));
            const char* a1 = cA + (ptrdiff_t)(t + 1) * kstepA;
            const char* a2 = last ? nA : cA + (ptrdiff_t)(t + 2) * kstepA; const char* b2 = last ? nB : cB + (ptrdiff_t)(t + 2) * kstepB;
            const char* a3 = a2 + kstepA; const char* b3 = b2 + kstepB;
            PG8_LDB(B0, 0, 0); PG8_LDB(B1, 0, 1); PG8_SCHED; PG8_LDA(At, 0, 0); PG8_STAGE(PG8_SA(1, 1), a1 + hstepA, voffA);
            PG8_WAIT_V(8); PG8_WAIT_L(0); PG8_BAR; PG8_MMA(0, 0, At, B0); PG8_MMA(0, 1, At, B1); PG8_BAR; PG8_SCHED;
            PG8_LDA(At, 0, 1); PG8_STAGE(PG8_SB(0, 0), b2, voffB); PG8_STAGE(PG8_SB(0, 1), b2 + hstepB, voffB); PG8_STAGE(PG8_SA(0, 0), a2, voffA);
            PG8_WAIT_V(8); PG8_WAIT_L(0); PG8_BAR; PG8_MMA(1, 0, At, B0); PG8_MMA(1, 1, At, B1); PG8_BAR; PG8_SCHED;
            PG8_LDB(B0, 1, 0); PG8_LDB(B1, 1, 1); PG8_SCHED; PG8_LDA(At, 1, 0); PG8_STAGE(PG8_SA(0, 1), a2 + hstepA, voffA);
            PG8_WAIT_V(8); PG8_WAIT_L(0); PG8_BAR; PG8_MMA(0, 0, At, B0); PG8_MMA(0, 1, At, B1); PG8_BAR; PG8_SCHED;
            PG8_LDA(At, 1, 1); PG8_STAGE(PG8_SB(1, 0), b3, voffB); PG8_STAGE(PG8_SB(1, 1), b3 + hstepB, voffB); PG8_STAGE(PG8_SA(1, 0), a3, voffA);
            PG8_WAIT_V(8); PG8_WAIT_L(0); PG8_BAR; PG8_MMA(1, 0, At, B0); PG8_MMA(1, 1, At, B1); PG8_BAR; PG8_SCHED;
        }
        if (wr == 0) PG8_BAR;
        { int frx = fr, fqx = fq; asm volatile("" : "+v"(frx), "+v"(fqx)); E(acc, cur, wr, wc, frx, fqx); }
        if (!has_next) break;
#pragma unroll
        for (int a = 0; a < 2; ++a)
#pragma unroll
            for (int b = 0; b < 2; ++b)
#pragma unroll
                for (int m = 0; m < 4; ++m)
#pragma unroll
                    for (int n = 0; n < 2; ++n) acc[a][b][m][n] = (f32x4){0.f, 0.f, 0.f, 0.f};
        cur = nxt; cA = nA; cB = nB; ++ui;
        if (wr == 1) PG8_BAR;
    }
    PG8_WAIT_V(0);
    PG8_BAR;
#undef PG8_UA
#undef PG8_UB
#undef PG8_SA
#undef PG8_SB
#undef PG8_STAGE
#undef PG8_LDA
#undef PG8_LDB
#undef PG8_MMA
#undef PG8_WAIT_V
#undef PG8_WAIT_L
#undef PG8_BAR
#undef PG8_SCHED
}

#define EPI_BEGIN \
    _Pragma("unroll") for (int ai = 0; ai < 2; ++ai) _Pragma("unroll") for (int m = 0; m < 4; ++m) { \
        const int row = u.pm * 256 + ai * 128 + wr * 64 + m * 16 + fr; \
        _Pragma("unroll") for (int bj = 0; bj < 2; ++bj) { \
            const int col = u.pn * 256 + bj * 128 + wc * 32 + 8 * fq; \
            f32x4 v0 = acc[ai][bj][m][0], v1 = acc[ai][bj][m][1];
#define EPI_END } if (m == 3) asm volatile("" ::: "memory"); }
#define EPI_SIG const f32x4 (&acc)[2][2][4][2], const Unit& u, int wr, int wc, int fr, int fq

struct EpiStore { bf16_t* O; size_t gs; int ldc;
    __device__ __forceinline__ void operator()(EPI_SIG) const {
        EPI_BEGIN *(u32x4*)(O + (size_t)u.g * gs + (size_t)row * ldc + col) = pack8(v0, v1); EPI_END } };
struct EpiIn { bf16_t* Ug; bf16_t* zx; bf16_t* gates; bf16_t* Kpe; const float* qg; const float* kg; const float* cosT; const float* sinT; LAS unsigned char* lds;
    __device__ __forceinline__ void operator()(EPI_SIG) const {
        if (u.pn < 2) { EPI_BEGIN *(u32x4*)(Ug + ((size_t)((col >> 4) * NCH + (row >> 6)) * 1024 + (row & 63) * 16 + (col & 15))) = pack8(v0, v1); EPI_END }
        else if (u.pn < 4) {
            const bool isq = (u.pn == 2); const int lane = fr + 16 * fq;
            LAS float* red = (LAS float*)(lds + 131072 + 1024);
#pragma unroll
            for (int ai = 0; ai < 2; ++ai)
#pragma unroll
                for (int m = 0; m < 4; ++m) { float p = 0.f;
#pragma unroll
                    for (int bj = 0; bj < 2; ++bj) if (isq || bj == 0) { const f32x4 a = acc[ai][bj][m][0], b = acc[ai][bj][m][1];
                        p += (a[0] * a[0] + a[1] * a[1]) + (a[2] * a[2] + a[3] * a[3]) + (b[0] * b[0] + b[1] * b[1]) + (b[2] * b[2] + b[3] * b[3]); }
                    p += shflx(p, 16, lane); p += shflx(p, 32, lane);
                    if (fq == 0) red[(ai * 128 + wr * 64 + m * 16 + fr) * 4 + wc] = p; }
            asm volatile("s_waitcnt lgkmcnt(0)" ::: "memory"); __builtin_amdgcn_s_barrier(); asm volatile("" ::: "memory");
            const float invn = isq ? (1.0f / 256.0f) : (1.0f / 128.0f);
#pragma unroll
            for (int ai = 0; ai < 2; ++ai)
#pragma unroll
                for (int m = 0; m < 4; ++m) { const int rl = ai * 128 + wr * 64 + m * 16 + fr, row = u.pm * 256 + rl;
                    const f32x4 ps = *(const LAS f32x4*)(red + rl * 4); const float r = rsqrtf(((ps[0] + ps[1]) + (ps[2] + ps[3])) * invn + EPS);
#pragma unroll
                    for (int bj = 0; bj < 2; ++bj) { const int cl = bj * 128 + wc * 32 + 8 * fq; f32x4 v0 = acc[ai][bj][m][0], v1 = acc[ai][bj][m][1];
                        if (isq || bj == 0) { const float* gp = isq ? qg + cl : kg + cl; const f32x4 g0 = *(const f32x4*)gp, g1 = *(const f32x4*)(gp + 4);
                            v0 = v0 * r * g0; v1 = v1 * r * g1; *(u32x4*)(zx + (size_t)row * 512 + (isq ? 0 : 256) + cl) = pack8(v0, v1); }
                        else if (wc == 0) { const int i0 = 4 * fq; const f32x4 c4 = *(const f32x4*)(cosT + (size_t)row * 16 + i0), s4 = *(const f32x4*)(sinT + (size_t)row * 16 + i0);
                            f32x4 o0, o1;
                            o0[0] = v0[0] * c4[0] - v0[1] * s4[0]; o0[1] = v0[1] * c4[0] + v0[0] * s4[0]; o0[2] = v0[2] * c4[1] - v0[3] * s4[1]; o0[3] = v0[3] * c4[1] + v0[2] * s4[1];
                            o1[0] = v1[0] * c4[2] - v1[1] * s4[2]; o1[1] = v1[1] * c4[2] + v1[0] * s4[2]; o1[2] = v1[2] * c4[3] - v1[3] * s4[3]; o1[3] = v1[3] * c4[3] + v1[2] * s4[3];
                            *(u32x4*)(Kpe + (size_t)row * 32 + 8 * fq) = pack8(o0, o1); } } }
            asm volatile("s_waitcnt lgkmcnt(0)" ::: "memory"); __builtin_amdgcn_s_barrier(); asm volatile("" ::: "memory");
        }
        else { EPI_BEGIN
#pragma unroll
            for (int i = 0; i < 4; ++i) { v0[i] = sigmoidf_(v0[i]); v1[i] = sigmoidf_(v1[i]); }
            *(u32x4*)(gates + (size_t)row * 2048 + (col - 1024)) = pack8(v0, v1); EPI_END } } };
struct EpiQ { bf16_t* Q; const float* cosT; const float* sinT; float scale;
    __device__ __forceinline__ void operator()(EPI_SIG) const {
        EPI_BEGIN
            const int head = col / 96, d = col - head * 96;
            v0 = v0 * scale; v1 = v1 * scale;
            if (d >= 64) { const int i0 = (d - 64) >> 1; const f32x4 c4 = *(const f32x4*)(cosT + (size_t)row * 16 + i0), s4 = *(const f32x4*)(sinT + (size_t)row * 16 + i0);
                const f32x4 a = v0, b = v1;
                v0[0] = a[0] * c4[0] - a[1] * s4[0]; v0[1] = a[1] * c4[0] + a[0] * s4[0]; v0[2] = a[2] * c4[1] - a[3] * s4[1]; v0[3] = a[3] * c4[1] + a[2] * s4[1];
                v1[0] = b[0] * c4[2] - b[1] * s4[2]; v1[1] = b[1] * c4[2] + b[0] * s4[2]; v1[2] = b[2] * c4[3] - b[3] * s4[3]; v1[3] = b[3] * c4[3] + b[2] * s4[3]; }
            *(u32x4*)(Q + (size_t)row * 768 + col) = pack8(v0, v1);
        EPI_END } };
struct EpiS { float* S;
    __device__ __forceinline__ void operator()(EPI_SIG) const {
        EPI_BEGIN if (bj == 0) { float* p = S + ((size_t)u.g * NCH + row) * 128 + col; *(f32x4*)p = v0; *(f32x4*)(p + 4) = v1; } EPI_END } };
struct EpiE { const bf16_t* ypart; const bf16_t* Ug; const float* dskip; bf16_t* ya;
    __device__ __forceinline__ void operator()(EPI_SIG) const {
        EPI_BEGIN
            const size_t off = ((size_t)u.g * NCH + row) * 1024 + col;
            f32x4 p0, p1, u0, u1; unpack8(*(const u32x4*)(ypart + off), p0, p1); unpack8(*(const u32x4*)(Ug + off), u0, u1);
            const float* dp = dskip + u.g * 16 + (col & 15); const f32x4 d0 = *(const f32x4*)dp, d1 = *(const f32x4*)(dp + 4);
            v0 = v0 + p0 + d0 * u0; v1 = v1 + p1 + d1 * u1;
#pragma unroll
            for (int i = 0; i < 4; ++i) { v0[i] = gelu_tanh(v0[i]); v1[i] = gelu_tanh(v1[i]); }
            *(u32x4*)(ya + ((size_t)row * 64 + (col >> 4)) * 512 + u.g * 16 + (col & 15)) = pack8(v0, v1);
        EPI_END } };
struct EpiGlu { const bf16_t* ya; const float* bias; bf16_t* yg;
    __device__ __forceinline__ void operator()(EPI_SIG) const {
        EPI_BEGIN
            f32x4 y0, y1; unpack8(*(const u32x4*)(ya + (size_t)row * 512 + col), y0, y1);
            const f32x4 b0 = *(const f32x4*)(bias + col), b1 = *(const f32x4*)(bias + col + 4);
#pragma unroll
            for (int i = 0; i < 4; ++i) { v0[i] = y0[i] * sigmoidf_(v0[i] + b0[i]); v1[i] = y1[i] * sigmoidf_(v1[i] + b1[i]); }
            *(u32x4*)(yg + (size_t)row * 512 + col) = pack8(v0, v1);
        EPI_END } };
template <bool ACCUM> struct EpiMerge { const bf16_t* gates; int goff; bf16_t* mg;
    __device__ __forceinline__ void operator()(EPI_SIG) const {
        EPI_BEGIN
            f32x4 g0, g1; unpack8(*(const u32x4*)(gates + (size_t)row * 2048 + goff + col), g0, g1);
            v0 = v0 * g0; v1 = v1 * g1;
            if (ACCUM) { f32x4 o0, o1; unpack8(*(const u32x4*)(mg + (size_t)row * 1024 + col), o0, o1); v0 = v0 + o0; v1 = v1 + o1; }
            *(u32x4*)(mg + (size_t)row * 1024 + col) = pack8(v0, v1);
        EPI_END } };
struct EpiMerge2 { const bf16_t* gates; bf16_t* mg;
    __device__ __forceinline__ void operator()(EPI_SIG) const {
        if (u.g == 0) { EpiMerge<false> e{gates, 0, mg}; e(acc, u, wr, wc, fr, fq); } else { EpiMerge<true> e{gates, 1024, mg}; e(acc, u, wr, wc, fr, fq); } } };
struct EpiRes { const float* xin; float* xout; const float* gmod;
    __device__ __forceinline__ void operator()(EPI_SIG) const {
        EPI_BEGIN
            const float* gp = gmod + (row >= SEQ ? 6144 : 0) + col; const f32x4 g0 = *(const f32x4*)gp, g1 = *(const f32x4*)(gp + 4);
            const float* xp = xin + (size_t)row * 1024 + col; float* op = xout + (size_t)row * 1024 + col;
            const f32x4 x0 = *(const f32x4*)xp, x1 = *(const f32x4*)(xp + 4);
            *(f32x4*)op = x0 + g0 * v0; *(f32x4*)(op + 4) = x1 + g1 * v1;
        EPI_END } };
struct EpiGU { bf16_t* hid;
    __device__ __forceinline__ void operator()(EPI_SIG) const {
        EPI_BEGIN
#pragma unroll
            for (int i = 0; i < 4; ++i) v0[i] = v0[i] * sigmoidf_(v0[i]) * v1[i];
            u32x2 w; w.x = cvt_pk_bf16(v0[0], v0[1]); w.y = cvt_pk_bf16(v0[2], v0[3]);
            *(u32x2*)(hid + (size_t)row * DFF + (col >> 1)) = w;
        EPI_END } };
}

namespace att {
constexpr int KSTR = 208, VSTR = 144, KBUF = 64 * KSTR, VBUF = 64 * VSTR, OFF_V = 3 * KBUF, OFF_P = OFF_V + 3 * VBUF, LDS_BYTES = OFF_P + 768;
constexpr float NEG = -1.0e30f;

__device__ __forceinline__ void phase(LAS unsigned char* lds, const bf16_t* __restrict__ Q, const bf16_t* __restrict__ Kn, const bf16_t* __restrict__ Kpe, const bf16_t* __restrict__ Vt,
                                      bf16_t* __restrict__ O, const int* __restrict__ pos, const int* __restrict__ tmin, const int* __restrict__ tmax, int G, int c, int tid_in) {
    int tid_ = tid_in; asm volatile("" : "+v"(tid_));
    const int tid = tid_, wave = __builtin_amdgcn_readfirstlane(tid >> 6), lane = tid & 63, q32 = lane & 31, hi = lane >> 5;
    for (int ui = c; ui < 1024; ui += G) {
        const int rnd = ui >> 8, c8 = ui & 255, cc = (G == 256) ? ((2 * (c8 & 7) + (c8 >> 7)) * 16 + ((c8 >> 3) & 15)) : c8, bh = cc >> 4, j16 = cc & 15;
        const int qb = rnd == 0 ? 63 - j16 : rnd == 1 ? 32 + j16 : rnd == 2 ? 31 - j16 : j16;
        const int b = bh >> 3, h = bh & 7;
        const int* tmn = tmin + b * 256; const int* tmx = tmax + b * 256;
        int qmax = tmx[qb * 4], qmin = tmn[qb * 4];
#pragma unroll
        for (int i = 1; i < 4; ++i) { qmax = max(qmax, tmx[qb * 4 + i]); qmin = min(qmin, tmn[qb * 4 + i]); }
        const size_t tok0 = (size_t)b * SEQ;
        const size_t qrow = tok0 + qb * 256 + wave * 32 + q32;
        bf16x8 qf[6];
        { const bf16_t* qp = Q + qrow * 768 + h * 96 + 8 * hi;
#pragma unroll
          for (int j = 0; j < 6; ++j) qf[j] = *(const bf16x8*)(qp + 16 * j); }
        const int posq = pos[qrow];
        f32x16 o0, o1;
#pragma unroll
        for (int r = 0; r < 16; ++r) { o0[r] = 0.f; o1[r] = 0.f; }
        float mrun = NEG, lrun = 0.f;
        const int krow = tid >> 3, kpc = tid & 7, prow = (tid & 255) >> 2, ppc = tid & 3;
        const bf16_t* kn_src = Kn + (tok0 + krow) * 512 + h * 64 + kpc * 8;
        const bf16_t* kp_src = Kpe + (tok0 + prow) * 32 + ppc * 8;
        const bf16_t* vt_src = Vt + (size_t)(h * 64 + krow) * T + tok0 + kpc * 8;
        const int* ps_src = pos + tok0 + (tid & 63);
        unsigned long long vm[4], mm[4];
#pragma unroll
        for (int i = 0; i < 4; ++i) { const int a_ = tmn[lane + 64 * i], b_ = tmx[lane + 64 * i]; vm[i] = __builtin_amdgcn_ballot_w64(a_ <= qmax); mm[i] = __builtin_amdgcn_ballot_w64(b_ > qmin); }
        int it_w = 0; unsigned long long it_c = vm[0], it_m = mm[0];
#define ATT_ITER(res_) do { \
            while (it_c == 0ull && it_w < 3) { ++it_w; it_c = it_w == 1 ? vm[1] : it_w == 2 ? vm[2] : vm[3]; it_m = it_w == 1 ? mm[1] : it_w == 2 ? mm[2] : mm[3]; } \
            if (it_c == 0ull) res_ = 256; \
            else { const int b_ = (int)__builtin_ctzll(it_c); res_ = 64 * it_w + b_ + (int)((it_m >> b_) & 1ull) * 512; it_c &= it_c - 1ull; } } while (0)
        u32x4 rkA, rpA, rvA, rkB, rpB, rvB; int rposA = 0, rposB = 0;
        rpA = (u32x4){0u, 0u, 0u, 0u}; rpB = rpA;
#define ATT_LOAD(S, kt_) do { rk##S = *(const u32x4*)(kn_src + (size_t)(kt_) * 64 * 512); if (tid < 256) rp##S = *(const u32x4*)(kp_src + (size_t)(kt_) * 64 * 32); \
        rv##S = *(const u32x4*)(vt_src + (size_t)(kt_) * 64); if (tid < 64) rpos##S = ps_src[(kt_) * 64]; } while (0)
#define ATT_STORE(S, bf_) do { *(LAS u32x4*)(lds + (bf_) * KBUF + krow * KSTR + kpc * 16) = rk##S; if (tid < 256) *(LAS u32x4*)(lds + (bf_) * KBUF + prow * KSTR + 128 + ppc * 16) = rp##S; \
        LAS unsigned char* vp_ = lds + OFF_V + (bf_) * VBUF + krow * VSTR + (kpc >> 1) * 32 + (kpc & 1) * 8; *(LAS u32x2*)vp_ = (u32x2){rv##S.x, rv##S.y}; *(LAS u32x2*)(vp_ + 16) = (u32x2){rv##S.z, rv##S.w}; \
        if (tid < 64) *(LAS int*)(lds + OFF_P + (bf_) * 256 + tid * 4) = rpos##S; } while (0)
#define ATT_QK(bf_) do { \
            const LAS unsigned char* kb = lds + (bf_) * KBUF + q32 * KSTR + hi * 16; \
            bf16x8 kf0[6], kf1[6]; \
            _Pragma("unroll") for (int j = 0; j < 6; ++j) { kf0[j] = *(const LAS bf16x8*)(kb + j * 32); kf1[j] = *(const LAS bf16x8*)(kb + 32 * KSTR + j * 32); } \
            _Pragma("unroll") for (int r = 0; r < 16; ++r) { s0[r] = 0.f; s1[r] = 0.f; } \
            _Pragma("unroll") for (int j = 0; j < 6; ++j) { s0 = __builtin_amdgcn_mfma_f32_32x32x16_bf16(kf0[j], qf[j], s0, 0, 0, 0); s1 = __builtin_amdgcn_mfma_f32_32x32x16_bf16(kf1[j], qf[j], s1, 0, 0, 0); } \
        } while (0)
#define ATT_SM(bf_, kt_) do { \
            const bool need_mask = ((kt_) & 512) != 0; \
            if (need_mask) { \
                const LAS int* pp = (const LAS int*)(lds + OFF_P + (bf_) * 256) + 4 * hi; \
                _Pragma("unroll") for (int i = 0; i < 4; ++i) { \
                    const i32x4 p0 = *(const LAS i32x4*)(pp + 8 * i), p1 = *(const LAS i32x4*)(pp + 32 + 8 * i); \
                    _Pragma("unroll") for (int e = 0; e < 4; ++e) { if (p0[e] > posq) s0[4 * i + e] = NEG; if (p1[e] > posq) s1[4 * i + e] = NEG; } } } \
            float mx = __builtin_amdgcn_fmed3f(s0[0], s1[0], INFINITY); \
            _Pragma("unroll") for (int r = 1; r < 16; ++r) { mx = __builtin_amdgcn_fmed3f(mx, s0[r], INFINITY); mx = __builtin_amdgcn_fmed3f(mx, s1[r], INFINITY); } \
            mx = __builtin_amdgcn_fmed3f(mx, shflx(mx, 32, lane), INFINITY); \
            if (__builtin_amdgcn_ballot_w64(mx > mrun) != 0ull) { \
                const float mnew = fmaxf(mrun, mx); const float alpha = __builtin_amdgcn_exp2f(mrun - mnew); mrun = mnew; lrun *= alpha; \
                _Pragma("unroll") for (int r = 0; r < 16; ++r) { o0[r] *= alpha; o1[r] *= alpha; } } \
            { const f32x2 m2 = (f32x2){mrun, mrun}; f32x2 ls2 = (f32x2){0.f, 0.f}; \
              _Pragma("unroll") for (int r = 0; r < 16; r += 2) { \
                  f32x2 a_ = (f32x2){s0[r], s0[r + 1]} - m2, b_ = (f32x2){s1[r], s1[r + 1]} - m2; \
                  a_.x = __builtin_amdgcn_exp2f(a_.x); a_.y = __builtin_amdgcn_exp2f(a_.y); b_.x = __builtin_amdgcn_exp2f(b_.x); b_.y = __builtin_amdgcn_exp2f(b_.y); \
                  s0[r] = a_.x; s0[r + 1] = a_.y; s1[r] = b_.x; s1[r + 1] = b_.y; ls2 += a_; ls2 += b_; } \
              lrun += ls2.x + ls2.y; } \
            _Pragma("unroll") for (int jj = 0; jj < 2; ++jj) { \
                u32x4 w0, w1; \
                w0.x = cvt_pk_bf16(s0[8 * jj + 0], s0[8 * jj + 1]); w0.y = cvt_pk_bf16(s0[8 * jj + 2], s0[8 * jj + 3]); w0.z = cvt_pk_bf16(s0[8 * jj + 4], s0[8 * jj + 5]); w0.w = cvt_pk_bf16(s0[8 * jj + 6], s0[8 * jj + 7]); \
                w1.x = cvt_pk_bf16(s1[8 * jj + 0], s1[8 * jj + 1]); w1.y = cvt_pk_bf16(s1[8 * jj + 2], s1[8 * jj + 3]); w1.z = cvt_pk_bf16(s1[8 * jj + 4], s1[8 * jj + 5]); w1.w = cvt_pk_bf16(s1[8 * jj + 6], s1[8 * jj + 7]); \
                pb[0][jj] = __builtin_bit_cast(bf16x8, w0); pb[1][jj] = __builtin_bit_cast(bf16x8, w1); } \
        } while (0)
#define ATT_PV(bf_) do { \
            const LAS unsigned char* vb = lds + OFF_V + (bf_) * VBUF + q32 * VSTR + hi * 16; \
            bf16x8 vfa[4], vfb[4]; \
            _Pragma("unroll") for (int xj = 0; xj < 4; ++xj) { vfa[xj] = *(const LAS bf16x8*)(vb + 32 * xj); vfb[xj] = *(const LAS bf16x8*)(vb + 32 * VSTR + 32 * xj); } \
            _Pragma("unroll") for (int x = 0; x < 2; ++x) _Pragma("unroll") for (int jj = 0; jj < 2; ++jj) { \
                o0 = __builtin_amdgcn_mfma_f32_32x32x16_bf16(vfa[2 * x + jj], pb[x][jj], o0, 0, 0, 0); \
                o1 = __builtin_amdgcn_mfma_f32_32x32x16_bf16(vfb[2 * x + jj], pb[x][jj], o1, 0, 0, 0); } \
        } while (0)
        f32x16 s0, s1; bf16x8 pb[2][2];
        const bool lateg = (wave & 4) != 0;
        int cur, nxt, t2, st = 0, stp = 0; bool havep = false;
        ATT_ITER(cur); nxt = 256; if (cur != 256) ATT_ITER(nxt);
        if (cur != 256) { ATT_LOAD(A, (cur & 255)); ATT_STORE(A, 0); }
        if (nxt != 256) ATT_LOAD(B, (nxt & 255));
        __syncthreads();
        while (cur != 256) {
            { const int st1 = st == 2 ? 0 : st + 1;
              t2 = 256; if (nxt != 256) ATT_ITER(t2);
              if (t2 != 256) ATT_LOAD(A, (t2 & 255));
              if (lateg) { if (havep) ATT_PV(stp); ATT_QK(st); ATT_SM(st, cur); havep = true; stp = st; }
              else { ATT_QK(st); ATT_SM(st, cur); ATT_PV(st); }
              if (nxt != 256) ATT_STORE(B, st1);
              __syncthreads();
              cur = nxt; nxt = t2; st = st1; }
            if (cur == 256) break;
            { const int st1 = st == 2 ? 0 : st + 1;
              t2 = 256; if (nxt != 256) ATT_ITER(t2);
              if (t2 != 256) ATT_LOAD(B, (t2 & 255));
              if (lateg) { if (havep) ATT_PV(stp); ATT_QK(st); ATT_SM(st, cur); havep = true; stp = st; }
              else { ATT_QK(st); ATT_SM(st, cur); ATT_PV(st); }
              if (nxt != 256) ATT_STORE(A, st1);
              __syncthreads();
              cur = nxt; nxt = t2; st = st1; }
        }
        if (lateg && havep) ATT_PV(stp);
        __syncthreads();
        const float ltot = lrun + shflx(lrun, 32, lane);
        const float inv = 1.0f / ltot;
        bf16_t* op = O + qrow * 512 + h * 64 + 4 * hi;
#pragma unroll
        for (int i = 0; i < 4; ++i) {
            u32x2 w; w.x = cvt_pk_bf16(o0[4 * i] * inv, o0[4 * i + 1] * inv); w.y = cvt_pk_bf16(o0[4 * i + 2] * inv, o0[4 * i + 3] * inv);
            *(u32x2*)(op + 8 * i) = w;
            u32x2 w2; w2.x = cvt_pk_bf16(o1[4 * i] * inv, o1[4 * i + 1] * inv); w2.y = cvt_pk_bf16(o1[4 * i + 2] * inv, o1[4 * i + 3] * inv);
            *(u32x2*)(op + 32 + 8 * i) = w2; }
#undef ATT_LOAD
#undef ATT_STORE
#undef ATT_QK
#undef ATT_SM
#undef ATT_PV
#undef ATT_ITER
    }
}
}


constexpr int NWAVES = 8, NTHR = 512;
constexpr int LDS_BYTES = 131072 + 1024 + 4096;

typedef const Params __attribute__((address_space(4)))* KArg;
struct Ctx { int tid, lane, wave, G, c, gw, NGW; LAS unsigned char* lds; };

enum { I_X = 0, I_C, I_POS, I_WADA, I_BADA, I_N1G, I_WIN, I_AR, I_AI, I_LDT, I_BR, I_BI, I_CR, I_CI, I_SD, I_WGLU, I_BGLU, I_WAOUT, I_QNG, I_WUQ, I_KVNG, I_WUK, I_WUV, I_WBOUT, I_WOUT, I_N2G, I_WGATE, I_WUP, I_WDOWN, I_FING };

__device__ __forceinline__ void sincos_acc(double x, float& s, float& c) {
    const double rev = x * 0.15915494309189535; const double r = rev - __builtin_rint(rev);
    const float th = (float)(r * 6.283185307179586);
    s = sinf(th); c = cosf(th);
}
__device__ __forceinline__ float inv_freq_tab(int i) {
    switch (i) { case 0: return 1.0f; case 1: return 0.5623413324356079f; case 2: return 0.3162277638912201f; case 3: return 0.17782793939113617f; case 4: return 0.10000000149011612f;
    case 5: return 0.05623413249850273f; case 6: return 0.03162277489900589f; case 7: return 0.017782794311642647f; case 8: return 0.009999999776482582f; case 9: return 0.005623413249850273f;
    case 10: return 0.003162277629598975f; case 11: return 0.0017782794311642647f; case 12: return 0.0010000000474974513f; case 13: return 0.000562341301701963f; case 14: return 0.0003162277571391314f;
    default: return 0.00017782794020604342f; }
}
__device__ __forceinline__ void p0_mod(const Ctx& X, KArg P) {
    LAS float* sc = (LAS float*)X.lds;
    LAS float* red = sc + 2048;
    const float* cin = P->in[I_C];
    for (int i = X.tid; i < 2048; i += NTHR) { const float v = cin[i]; sc[i] = v * sigmoidf_(v); }
    __syncthreads();
    float* mod = (float*)(P->ws + WS_MOD);
    for (int unit = X.c; unit < DEPTH * 96; unit += X.G) {
        const int l = unit / 96, cb = unit % 96, kp = X.tid >> 6, cj = X.tid & 63, col = cb * 64 + cj;
        const float* w = P->in[I_WADA] + ((size_t)l * 1024 + kp * 128) * 6144 + col;
        float a0 = 0.f, a1 = 0.f;
#pragma unroll 8
        for (int k = 0; k < 128; ++k) { const float wv = w[(size_t)k * 6144]; a0 += sc[kp * 128 + k] * wv; a1 += sc[1024 + kp * 128 + k] * wv; }
        red[(kp * 64 + cj) * 2] = a0; red[(kp * 64 + cj) * 2 + 1] = a1;
        __syncthreads();
        if (X.tid < 128) { const int b = X.tid >> 6, cj2 = X.tid & 63; float s = 0.f;
#pragma unroll
            for (int q = 0; q < 8; ++q) s += red[(q * 64 + cj2) * 2 + b];
            mod[((size_t)l * 2 + b) * 6144 + cb * 64 + cj2] = s + P->in[I_BADA][(size_t)l * 6144 + cb * 64 + cj2]; }
        __syncthreads();
    }
}
__device__ __forceinline__ void p0_tables(const Ctx& X, KArg P) {
    const int* pos = (const int*)P->in[I_POS];
    float* cosT = (float*)(P->ws + WS_ROPE); float* sinT = cosT + (size_t)T * 16;
    for (int idx = X.c * NTHR + X.tid; idx < T * 16; idx += X.G * NTHR) {
        const int tok = idx >> 4, i = idx & 15;
        const float ang = (float)pos[tok] * inv_freq_tab(i);
        float s, c; sincos_acc((double)ang, s, c);
        cosT[idx] = c; sinT[idx] = s;
    }
    int* tmin = (int*)(P->ws + WS_TPOS); int* tmax = tmin + 512;
    for (int t = X.gw; t < 512; t += X.NGW) {
        int v = pos[t * 64 + X.lane], mn = v, mx = v;
#pragma unroll
        for (int o = 1; o < 64; o <<= 1) { mn = min(mn, shflxi(mn, o, X.lane)); mx = max(mx, shflxi(mx, o, X.lane)); }
        if (X.lane == 0) { tmin[t] = mn; tmax[t] = mx; }
    }
}
__device__ __forceinline__ void ssm_stage1(const Ctx& X, KArg P, int l) {
    const float* a_re = P->in[I_AR] + (size_t)l * NG * SP; const float* a_im = P->in[I_AI] + (size_t)l * NG * SP; const float* ldt = P->in[I_LDT] + (size_t)l * NG;
    f32x2* apow = (f32x2*)(P->ws + WS_APOW); f32x2* bbar = (f32x2*)(P->ws + WS_BBAR);
    for (int idx = X.c * NTHR + X.tid; idx < NG * 66 * 64; idx += X.G * NTHR) {
        const int g = idx / (66 * 64), j = (idx >> 6) % 66, p = idx & 63;
        const float n = (j == 65) ? 2048.0f : (float)j;
        const float dt = expf(ldt[g]), ar = a_re[g * 64 + p], ai = a_im[g * 64 + p];
        const float mag = expf(ar * dt * n); float s, c; sincos_acc((double)ai * (double)dt * (double)n, s, c);
        apow[idx] = (f32x2){mag * c, mag * s};
    }
    const float* b_re = P->in[I_BR] + (size_t)l * NG * SP * 16; const float* b_im = P->in[I_BI] + (size_t)l * NG * SP * 16;
    for (int idx = X.c * NTHR + X.tid; idx < NG * 64 * 16; idx += X.G * NTHR) {
        const int g = idx >> 10, p = (idx >> 4) & 63;
        const float dt = expf(ldt[g]), ar = a_re[g * 64 + p], ai = a_im[g * 64 + p];
        const float mag = expf(ar * dt); float s, c; sincos_acc((double)ai * (double)dt, s, c);
        const float nr = mag * c - 1.0f, ni = mag * s, den = ar * ar + ai * ai;
        const float cr = (nr * ar + ni * ai) / den, ci = (ni * ar - nr * ai) / den;
        const float br = b_re[idx], bi = b_im[idx];
        bbar[idx] = (f32x2){cr * br - ci * bi, cr * bi + ci * br};
    }
}
__device__ __forceinline__ void ssm_stage2(const Ctx& X, KArg P, int l) {
    const f32x2* apow = (const f32x2*)(P->ws + WS_APOW); const f32x2* bbar = (const f32x2*)(P->ws + WS_BBAR);
    const float* c_re = P->in[I_CR] + (size_t)l * NG * 16 * SP; const float* c_im = P->in[I_CI] + (size_t)l * NG * 16 * SP;
    bf16_t* Kg = (bf16_t*)(P->ws + WS_KG); bf16_t* Et = (bf16_t*)(P->ws + WS_ET); bf16_t* Ft = (bf16_t*)(P->ws + WS_FT);
    for (int idx = X.c * NTHR + X.tid; idx < NG * 128 * 64; idx += X.G * NTHR) {
        const int g = idx >> 13, jj = (idx >> 6) & 127, m = (idx >> 2) & 15, mq = idx & 3;
        f32x4 acc = (f32x4){0.f, 0.f, 0.f, 0.f};
        if (jj >= 64) { const int j = jj - 64;
            const float* cr = c_re + (g * 16 + m) * 64; const float* ci = c_im + (g * 16 + m) * 64; const f32x2* ap = apow + (g * 66 + j) * 64; const f32x4* bb = (const f32x4*)(bbar + (size_t)g * 1024 + 4 * mq);
#pragma unroll 4
            for (int p = 0; p < 64; ++p) { const f32x2 a = ap[p]; const f32x4 b01 = bb[p * 8], b23 = bb[p * 8 + 1]; const float wr = cr[p] * a.x - ci[p] * a.y, wi = cr[p] * a.y + ci[p] * a.x;
                acc[0] += wr * b01[0] - wi * b01[1]; acc[1] += wr * b01[2] - wi * b01[3]; acc[2] += wr * b23[0] - wi * b23[1]; acc[3] += wr * b23[2] - wi * b23[3]; } }
        u32x2 w; w.x = cvt_pk_bf16(acc[0], acc[1]); w.y = cvt_pk_bf16(acc[2], acc[3]);
        *(u32x2*)(Kg + (size_t)idx * 4) = w;
    }
    for (int idx = X.c * NTHR + X.tid; idx < NG * 1024 * 128; idx += X.G * NTHR) {
        const int g = idx >> 17, n = (idx >> 7) & 1023, k = idx & 127, t = n >> 4, m = n & 15, p = k & 63;
        const f32x2 a = apow[(g * 66 + t + 1) * 64 + p]; const float cr = c_re[(g * 16 + m) * 64 + p], ci = c_im[(g * 16 + m) * 64 + p];
        const float wr = cr * a.x - ci * a.y, wi = cr * a.y + ci * a.x;
        Et[idx] = f2bf(k < 64 ? wr : -wi);
    }
    for (int idx = X.c * NTHR + X.tid; idx < NG * 128 * 1024; idx += X.G * NTHR) {
        const int g = idx >> 17, n = (idx >> 10) & 127, k = idx & 1023, s = k >> 4, mp = k & 15, p = n & 63;
        const f32x2 a = apow[(g * 66 + 63 - s) * 64 + p], b2 = bbar[(size_t)g * 1024 + p * 16 + mp];
        Ft[idx] = f2bf(n < 64 ? (a.x * b2.x - a.y * b2.y) : (a.x * b2.y + a.y * b2.x));
    }
}
struct SrcCol { const float* p; int ld; };
__device__ __forceinline__ SrcCol src_col(KArg P, int l, int mat, int n) {
    SrcCol r; r.p = nullptr; r.ld = 0;
    switch (mat) {
    case 0: { int s = -1; if (n < 896) s = n; else if (n < 928) { const int i = n - 896; s = 896 + (i >> 1) + (i & 1) * 16; } else if (n < 1024) s = -1; else if (n < 2048) s = 928 + (n - 1024); else s = 1952 + (n - 2048);
              r.ld = INC; if (s >= 0) r.p = P->in[I_WIN] + (size_t)l * 1024 * INC + s; } break;
    case 1: r.ld = 512; r.p = P->in[I_WGLU] + (size_t)l * 512 * 512 + n; break;
    case 2: r.ld = 1024; r.p = P->in[I_WAOUT] + (size_t)l * 512 * 1024 + n; break;
    case 3: r.ld = 1024; r.p = P->in[I_WBOUT] + (size_t)l * 512 * 1024 + n; break;
    case 4: { const int h = n / 96, d = n - h * 96; int s = n; if (d >= 64) { const int i = d - 64; s = h * 96 + 64 + (i >> 1) + (i & 1) * 16; }
              r.ld = 768; r.p = P->in[I_WUQ] + (size_t)l * 256 * 768 + s; } break;
    case 5: r.ld = 512; r.p = P->in[I_WUK] + (size_t)l * 128 * 512 + n; break;
    case 6: r.ld = 512; r.p = P->in[I_WUV] + (size_t)l * 128 * 512 + n; break;
    case 7: r.ld = 1024; r.p = P->in[I_WOUT] + (size_t)l * 1024 * 1024 + n; break;
    case 8: { const int g8 = n >> 3, q = n & 7; r.ld = DFF; r.p = (q < 4 ? P->in[I_WGATE] + (size_t)l * 1024 * DFF + 4 * g8 + q : P->in[I_WUP] + (size_t)l * 1024 * DFF + 4 * g8 + (q - 4)); } break;
    default: r.ld = 1024; r.p = P->in[I_WDOWN] + (size_t)l * DFF * 1024 + n; break;
    }
    return r;
}
template <int MAT, int K, int N>
__device__ __forceinline__ void weights_mat(const Ctx& X, KArg P, int l, bf16_t* Wdst, LAS float* scr, int base) {
    constexpr int nblk = N / 32, items = (K / 64) * nblk;
    const int first = ((X.gw - base) % X.NGW + X.NGW) % X.NGW;
    for (int it = first; it < items; it += X.NGW) {
        const int kb = it / nblk, nb = it % nblk, k0 = 64 * kb, n0 = 32 * nb;
        const SrcCol sc = src_col(P, l, MAT, n0 + (X.lane & 31));
#pragma unroll 8
        for (int i = 0; i < 32; ++i) { const int kk = 2 * i + (X.lane >> 5); scr[kk * 33 + (X.lane & 31)] = sc.p ? sc.p[(size_t)(k0 + kk) * sc.ld] : 0.f; }
        asm volatile("s_waitcnt lgkmcnt(0)" ::: "memory");
        const int ck = X.lane & 7;
#pragma unroll
        for (int j = 0; j < 4; ++j) { const int n = (X.lane >> 3) + 8 * j; const LAS float* s = scr + (8 * ck) * 33 + n;
            u32x4 o; o.x = cvt_pk_bf16(s[0], s[33]); o.y = cvt_pk_bf16(s[2 * 33], s[3 * 33]); o.z = cvt_pk_bf16(s[4 * 33], s[5 * 33]); o.w = cvt_pk_bf16(s[6 * 33], s[7 * 33]);
            *(u32x4*)(Wdst + (size_t)(n0 + n) * K + k0 + 8 * ck) = o; }
        asm volatile("s_waitcnt lgkmcnt(0)" ::: "memory");
    }
}
__device__ __forceinline__ void weights_phase(const Ctx& X, KArg P, int l) {
    bf16_t* W = (bf16_t*)(P->ws + WS_W);
    LAS float* scr = (LAS float*)(X.lds + X.wave * 8448);
    constexpr int I0 = 16 * 96, I1 = 8 * 16, I2 = 8 * 32, I3 = 8 * 32, I4 = 4 * 24, I5 = 2 * 16, I6 = 2 * 16, I7 = 16 * 32, I8 = 16 * 176;
    weights_mat<0, 1024, 3072>(X, P, l, W + WO_IN, scr, 0);
    weights_mat<1, 512, 512>(X, P, l, W + WO_GLU, scr, I0);
    weights_mat<2, 512, 1024>(X, P, l, W + WO_A, scr, I0 + I1);
    weights_mat<3, 512, 1024>(X, P, l, W + WO_B, scr, I0 + I1 + I2);
    weights_mat<4, 256, 768>(X, P, l, W + WO_UQ, scr, I0 + I1 + I2 + I3);
    weights_mat<5, 128, 512>(X, P, l, W + WO_UK, scr, I0 + I1 + I2 + I3 + I4);
    weights_mat<6, 128, 512>(X, P, l, W + WO_UV, scr, I0 + I1 + I2 + I3 + I4 + I5);
    weights_mat<7, 1024, 1024>(X, P, l, W + WO_OUT, scr, I0 + I1 + I2 + I3 + I4 + I5 + I6);
    weights_mat<8, 1024, 5632>(X, P, l, W + WO_GU, scr, I0 + I1 + I2 + I3 + I4 + I5 + I6 + I7);
    weights_mat<9, DFF, 1024>(X, P, l, W + WO_DOWN, scr, I0 + I1 + I2 + I3 + I4 + I5 + I6 + I7 + I8);
}
__device__ __forceinline__ void norm_phase(const Ctx& X, const float* x, const float* gain, const float* mod_sh, const float* mod_sc, bf16_t* h) {
    for (int row0 = X.gw; row0 < T; row0 += 2 * X.NGW) {
        const int row1 = row0 + X.NGW;
        const bool has1 = row1 < T;
        const f32x4* xr0 = (const f32x4*)(x + (size_t)row0 * 1024) + X.lane;
        const f32x4* xr1 = (const f32x4*)(x + (size_t)(has1 ? row1 : row0) * 1024) + X.lane;
        f32x4 v0[4], v1[4]; float ss0 = 0.f, ss1 = 0.f;
#pragma unroll
        for (int j = 0; j < 4; ++j) { v0[j] = xr0[64 * j]; v1[j] = xr1[64 * j]; }
#pragma unroll
        for (int j = 0; j < 4; ++j) { ss0 += (v0[j][0] * v0[j][0] + v0[j][1] * v0[j][1]) + (v0[j][2] * v0[j][2] + v0[j][3] * v0[j][3]);
                                      ss1 += (v1[j][0] * v1[j][0] + v1[j][1] * v1[j][1]) + (v1[j][2] * v1[j][2] + v1[j][3] * v1[j][3]); }
#pragma unroll
        for (int o = 1; o < 64; o <<= 1) { ss0 += shflx(ss0, o, X.lane); ss1 += shflx(ss1, o, X.lane); }
        const float r0 = rsqrtf(ss0 * (1.0f / 1024.0f) + EPS), r1 = rsqrtf(ss1 * (1.0f / 1024.0f) + EPS);
        const int bo0 = row0 >= SEQ ? 6144 : 0, bo1 = row1 >= SEQ ? 6144 : 0;
#pragma unroll
        for (int j = 0; j < 4; ++j) { const int col = 256 * j + 4 * X.lane;
            const f32x4 g4 = *(const f32x4*)(gain + col);
            { const f32x4 s4 = *(const f32x4*)(mod_sc + bo0 + col), h4 = *(const f32x4*)(mod_sh + bo0 + col);
              const f32x4 o = v0[j] * r0 * g4 * (s4 + 1.0f) + h4; u32x2 w; w.x = cvt_pk_bf16(o[0], o[1]); w.y = cvt_pk_bf16(o[2], o[3]);
              *(u32x2*)(h + (size_t)row0 * 1024 + col) = w; }
            if (has1) { const f32x4 s4 = *(const f32x4*)(mod_sc + bo1 + col), h4 = *(const f32x4*)(mod_sh + bo1 + col);
              const f32x4 o = v1[j] * r1 * g4 * (s4 + 1.0f) + h4; u32x2 w; w.x = cvt_pk_bf16(o[0], o[1]); w.y = cvt_pk_bf16(o[2], o[3]);
              *(u32x2*)(h + (size_t)row1 * 1024 + col) = w; } }
    }
}
__device__ __forceinline__ void final_norm_phase(const Ctx& X, float* x, const float* gain) {
    for (int row = X.gw; row < T; row += X.NGW) {
        f32x4* xr = (f32x4*)(x + (size_t)row * 1024) + X.lane;
        f32x4 v[4]; float ss = 0.f;
#pragma unroll
        for (int j = 0; j < 4; ++j) { v[j] = xr[64 * j]; ss += (v[j][0] * v[j][0] + v[j][1] * v[j][1]) + (v[j][2] * v[j][2] + v[j][3] * v[j][3]); }
        const float r = rsqrtf(wave_sum(ss, X.lane) * (1.0f / 1024.0f) + EPS);
#pragma unroll
        for (int j = 0; j < 4; ++j) { const f32x4 g4 = *(const f32x4*)(gain + 256 * j + 4 * X.lane); xr[64 * j] = v[j] * r * g4; }
    }
}
__device__ __forceinline__ void prep_phase(const Ctx& X, KArg P, int l) {
    bf16_t* zx = (bf16_t*)(P->ws + WS_ZX); bf16_t* Kpe = (bf16_t*)(P->ws + WS_KPE);
    const float* cosT = (const float*)(P->ws + WS_ROPE); const float* sinT = cosT + (size_t)T * 16;
    const float* qg = P->in[I_QNG] + (size_t)l * QL; const float* kg = P->in[I_KVNG] + (size_t)l * KVL;
    for (int row = X.gw; row < T; row += X.NGW) {
        bf16_t* zr = zx + (size_t)row * 512;
        const u32x2 cq = *(const u32x2*)(zr + 4 * X.lane); const unsigned ck = *(const unsigned*)(zr + 256 + 2 * X.lane);
        const float q0 = bflo(cq.x), q1 = bfhi(cq.x), q2 = bflo(cq.y), q3 = bfhi(cq.y), k0 = bflo(ck), k1 = bfhi(ck);
        const float rq = rsqrtf(wave_sum((q0 * q0 + q1 * q1) + (q2 * q2 + q3 * q3), X.lane) * (1.0f / 256.0f) + EPS);
        const float rk = rsqrtf(wave_sum(k0 * k0 + k1 * k1, X.lane) * (1.0f / 128.0f) + EPS);
        const f32x4 g4 = *(const f32x4*)(qg + 4 * X.lane); const f32x2 g2 = *(const f32x2*)(kg + 2 * X.lane);
        u32x2 wq; wq.x = cvt_pk_bf16(q0 * rq * g4[0], q1 * rq * g4[1]); wq.y = cvt_pk_bf16(q2 * rq * g4[2], q3 * rq * g4[3]);
        const unsigned wk = cvt_pk_bf16(k0 * rk * g2[0], k1 * rk * g2[1]);
        if (X.lane < 16) { const unsigned kr = *(const unsigned*)(zr + 384 + 2 * X.lane); const float x1 = bflo(kr), x2 = bfhi(kr);
            const float c = cosT[(size_t)row * 16 + X.lane], s = sinT[(size_t)row * 16 + X.lane];
            *(unsigned*)(Kpe + (size_t)row * 32 + 2 * X.lane) = cvt_pk_bf16(x1 * c - x2 * s, x2 * c + x1 * s); }
        *(u32x2*)(zr + 4 * X.lane) = wq; *(unsigned*)(zr + 256 + 2 * X.lane) = wk;
    }
}
__device__ __forceinline__ void carry_phase(const Ctx& X, KArg P) {
    const float* S = (const float*)(P->ws + WS_S); bf16_t* Hc = (bf16_t*)(P->ws + WS_HC); const f32x2* apow = (const f32x2*)(P->ws + WS_APOW);
    LAS f32x2* Ew = (LAS f32x2*)X.lds;
    const int cshift = X.G >= 64 ? X.G - 64 : 0;
    for (int i = X.c - cshift; i < 64; i += X.G) {
        if (i < 0) break;
        const int b = i >> 5, g = i & 31, p = X.lane, w = X.wave;
        const f32x2 a64 = apow[(g * 66 + 64) * 64 + p], a2k = apow[(g * 66 + 65) * 64 + p];
        const size_t r0 = ((size_t)g * NCH + b * 256 + w * 32) * 128;
        float hr = 0.f, hi = 0.f;
#pragma unroll 8
        for (int cc = 0; cc < 32; ++cc) { const float sr = S[r0 + cc * 128 + p], si = S[r0 + cc * 128 + 64 + p];
            const float nr = a64.x * hr - a64.y * hi + sr, ni = a64.x * hi + a64.y * hr + si; hr = nr; hi = ni; }
        Ew[w * 64 + p] = (f32x2){hr, hi};
        __syncthreads();
        hr = 0.f; hi = 0.f;
        for (int q = 0; q < w; ++q) { const f32x2 e = Ew[q * 64 + p]; const float nr = a2k.x * hr - a2k.y * hi + e.x, ni = a2k.x * hi + a2k.y * hr + e.y; hr = nr; hi = ni; }
#pragma unroll 8
        for (int cc = 0; cc < 32; ++cc) { const float sr = S[r0 + cc * 128 + p], si = S[r0 + cc * 128 + 64 + p];
            Hc[r0 + cc * 128 + p] = f2bf(hr); Hc[r0 + cc * 128 + 64 + p] = f2bf(hi);
            const float nr = a64.x * hr - a64.y * hi + sr, ni = a64.x * hi + a64.y * hr + si; hr = nr; hi = ni; }
        __syncthreads();
    }
}

#ifndef PHMASK
#define PHMASK 0xffffffffu
#endif
__global__ void __launch_bounds__(NTHR, 2) trunk_fwd(Params Pval) {
    extern __shared__ __attribute__((aligned(16))) unsigned char lds_raw[];
    cg::grid_group grid = cg::this_grid();
    Ctx X; X.lds = (LAS unsigned char*)lds_raw; X.tid = threadIdx.x; X.lane = X.tid & 63; X.wave = __builtin_amdgcn_readfirstlane(X.tid >> 6);
    X.G = gridDim.x; X.c = blockIdx.x; X.gw = X.c * NWAVES + X.wave; X.NGW = X.G * NWAVES;
    using pg8::Gemm; using pg8::Order;
    KArg P = (KArg)__builtin_amdgcn_kernarg_segment_ptr();
    unsigned char* ws;
    unsigned bar_epoch = 0;
#ifdef PROBE_PHASE
    unsigned long long probe_acc = 0, probe_t = 0; int probe_seg = -1;
#define PROBE_TICK() do { const unsigned long long now_ = __builtin_amdgcn_s_memrealtime(); if (probe_seg >= 0 && probe_seg < 16 && ((PROBE_PHASE >> probe_seg) & 1)) probe_acc += now_ - probe_t; probe_t = now_; ++probe_seg; } while (0)
#else
#define PROBE_TICK() do {} while (0)
#endif
    const unsigned my_xcc = (unsigned)__builtin_amdgcn_s_getreg((3 << 11) | 20) & 0xFu;
    volatile LAS unsigned* const bar_lds = (volatile LAS unsigned*)(X.lds + 131072);
#define BAR_LD(p) __hip_atomic_load((p), __ATOMIC_RELAXED, __HIP_MEMORY_SCOPE_AGENT)
#define BAR_ADD(p, v) __hip_atomic_fetch_add((p), (v), __ATOMIC_RELAXED, __HIP_MEMORY_SCOPE_AGENT)
    {
        unsigned* const bw = (unsigned*)(P->ws + WS_BAR);
        if (X.tid == 0) { BAR_ADD(bw + 64 * my_xcc, 1u); BAR_ADD(bw + 3200, 1u); while (BAR_LD(bw + 3200) < (unsigned)X.G) __builtin_amdgcn_s_sleep(1);
            unsigned nl = 1, nxc = 0;
            for (unsigned j = 0; j < 16; ++j) { const unsigned cj = BAR_LD(bw + 64 * j); if (cj) ++nxc; if (j == my_xcc) nl = cj; }
            bar_lds[0] = nl; bar_lds[1] = nxc ? nxc : 1u; }
        __syncthreads();
    }
#define GRID_SYNC() do { asm volatile("s_waitcnt vmcnt(0)" ::: "memory"); __syncthreads(); \
        asm volatile("" : "+s"(P)); unsigned* const bw_ = (unsigned*)(P->ws + WS_BAR); \
        unsigned lb_ = (unsigned)(size_t)X.lds + 131072u; asm volatile("" : "+s"(lb_)); unsigned xc_ = my_xcc; asm volatile("" : "+s"(xc_)); \
        if (X.tid == 0) { const unsigned nl_ = ((volatile LAS unsigned*)lb_)[0], nx_ = ((volatile LAS unsigned*)lb_)[1], k_ = bar_epoch; \
            const unsigned old_ = BAR_ADD(bw_ + 1024 + 64 * xc_, 1u); \
            if (old_ + 1u == (k_ + 1u) * nl_) { __builtin_amdgcn_fence(__ATOMIC_RELEASE, "agent"); asm volatile("s_waitcnt vmcnt(0)" ::: "memory"); \
                const unsigned og_ = BAR_ADD(bw_ + 3072, 1u); \
                if (og_ + 1u == (k_ + 1u) * nx_) BAR_ADD(bw_ + 3136, 1u); else while (BAR_LD(bw_ + 3136) <= k_) __builtin_amdgcn_s_sleep(1); \
                __builtin_amdgcn_fence(__ATOMIC_ACQUIRE, "agent"); BAR_ADD(bw_ + 2048 + 64 * xc_, 1u); asm volatile("s_waitcnt vmcnt(0)" ::: "memory"); } \
            else { while (BAR_LD(bw_ + 2048 + 64 * xc_) <= k_) __builtin_amdgcn_s_sleep(1); __builtin_amdgcn_fence(__ATOMIC_ACQUIRE, "agent"); asm volatile("s_waitcnt vmcnt(0)" ::: "memory"); } } \
        bar_epoch += 1; __syncthreads(); PROBE_TICK(); } while (0)
#define FRESH() do { asm volatile("" : "+s"(P)); asm volatile("v_mbcnt_lo_u32_b32 %0, -1, 0\n\tv_mbcnt_hi_u32_b32 %0, -1, %0" : "=v"(X.lane)); X.tid = X.wave * 64 + X.lane; ws = P->ws; } while (0)
#define mod ((float*)(ws + WS_MOD))
#define cosT ((const float*)(ws + WS_ROPE))
#define sinT (cosT + (size_t)T * 16)
#define tmin ((const int*)(ws + WS_TPOS))
#define tmax (tmin + 512)
#define Wb ((bf16_t*)(ws + WS_W))
#define Hb ((bf16_t*)(ws + WS_H))
#define Ug ((bf16_t*)(ws + WS_UG))
#define zx ((bf16_t*)(ws + WS_ZX))
#define gates ((bf16_t*)(ws + WS_GATES))
#define Qb ((bf16_t*)(ws + WS_Q))
#define Kn ((bf16_t*)(ws + WS_KN))
#define Kpe ((bf16_t*)(ws + WS_KPE))
#define Vt ((bf16_t*)(ws + WS_VT))
#define Ob ((bf16_t*)(ws + WS_O))
#define ypart ((bf16_t*)(ws + WS_YPART))
#define ya ((bf16_t*)(ws + WS_YA))
#define yg ((bf16_t*)(ws + WS_YG))
#define hid ((bf16_t*)(ws + WS_HID))
#define Sb ((float*)(ws + WS_S))
#define Hc ((bf16_t*)(ws + WS_HC))
#define modl (mod + (size_t)l * 2 * 6144)
#define xin ((l == 0) ? P->in[I_X] : (const float*)P->out)

#define PH(n) if (PHMASK & (1u << (n)))
    grid.sync();
    PH(0) { FRESH(); p0_mod(X, P); p0_tables(X, P); weights_phase(X, P, 0); ssm_stage1(X, P, 0); }
    GRID_SYNC();

    for (int l = 0; l < DEPTH; ++l) {
#ifdef PROBE_PHASE
        probe_seg = 0;
#endif
        if (l > 0) PH(1) { FRESH(); weights_phase(X, P, l); ssm_stage1(X, P, l); }
        PH(2) { FRESH(); norm_phase(X, xin, P->in[I_N1G] + (size_t)l * 1024, modl + 0, modl + 1024, Hb); }
        GRID_SYNC();
        PH(3) { FRESH(); ssm_stage2(X, P, l); }
        PH(4) { FRESH(); Gemm g{Hb, Wb + WO_IN, 1024, 1024, 0, 0, 1024}; Order S; S.init(T, 3072, 1, X.G, X.c); pg8::EpiIn E{Ug, zx, gates, Kpe, P->in[I_QNG] + (size_t)l * QL, P->in[I_KVNG] + (size_t)l * KVL, cosT, sinT, X.lds};
          pg8::gemm_phase<pg8::EpiIn, false>(X.lds, g, S, E, X.tid); }
        GRID_SYNC();
        PH(6) { FRESH(); Gemm g{Ug, (const bf16_t*)(ws + WS_FT), 1024, 1024, (size_t)NCH * 1024, (size_t)128 * 1024, 1024}; Order S; S.init(NCH, 256, NG, X.G, X.c); pg8::EpiS E{Sb};
          pg8::gemm_phase<pg8::EpiS, false>(X.lds, g, S, E, X.tid); }
        GRID_SYNC();
        PH(7) { FRESH(); carry_phase(X, P); }
        PH(8) { FRESH(); Gemm g{zx, Wb + WO_UQ, 512, 256, 0, 0, 256}; Order S; S.init(T, 768, 1, X.G, X.c); pg8::EpiQ E{Qb, cosT, sinT, 0.10206207261596577f * 1.4426950408889634f};
          pg8::gemm_phase<pg8::EpiQ, false>(X.lds, g, S, E, X.tid); }
        PH(9) { FRESH(); Gemm g{zx + 256, Wb + WO_UK, 512, 128, 0, 0, 128}; Order S; S.init(T, 512, 1, X.G, X.c); pg8::EpiStore E{Kn, 0, 512};
          pg8::gemm_phase<pg8::EpiStore, false>(X.lds, g, S, E, X.tid); }
        PH(10) { FRESH(); Gemm g{Wb + WO_UV, zx + 256, 128, 512, 0, 0, 128}; Order S; S.init(512, T, 1, X.G, X.c); pg8::EpiStore E{Vt, 0, T};
          pg8::gemm_phase<pg8::EpiStore, false>(X.lds, g, S, E, X.tid); }
        GRID_SYNC();
#ifdef ATT_DUMMY
        PH(11) { FRESH(); for (int idx = X.c * NTHR + X.tid; idx < T * 512; idx += X.G * NTHR) { const int row = idx >> 9, cc = idx & 511, h = cc >> 6, d = cc & 63;
            const float v = bf2f(Qb[(size_t)row * 768 + h * 96 + d]) + bf2f(Qb[(size_t)row * 768 + h * 96 + 64 + (d & 31)]) + bf2f(Kn[(size_t)row * 512 + cc]) + bf2f(Vt[(size_t)cc * T + row]) + bf2f(Kpe[(size_t)row * 32 + (d & 31)]);
            Ob[idx] = f2bf(v * 0.25f); } }
#else
        PH(11) { FRESH(); att::phase(X.lds, Qb, Kn, Kpe, Vt, Ob, (const int*)P->in[I_POS], tmin, tmax, X.G, X.c, X.tid); }
#endif
#ifdef SYNC_AFTER_ATT
        GRID_SYNC();
#endif
        PH(12) { FRESH(); Gemm g{Ug, (const bf16_t*)(ws + WS_KG) + 16384, 1024, 16, (size_t)NCH * 1024, 32768, 1024}; Order S; S.init(NCH, 1024, NG, X.G, X.c); pg8::EpiStore E{ypart, (size_t)NCH * 1024, 1024};
          pg8::gemm_phase<pg8::EpiStore, true>(X.lds, g, S, E, X.tid); }
        PH(13) { FRESH(); Gemm g{Hc, (const bf16_t*)(ws + WS_ET), 128, 128, (size_t)NCH * 128, (size_t)1024 * 128, 128}; Order S; S.init(NCH, 1024, NG, X.G, X.c);
          pg8::EpiE E{ypart, Ug, P->in[I_SD] + (size_t)l * SW, ya};
          pg8::gemm_phase<pg8::EpiE, false>(X.lds, g, S, E, X.tid); }
        GRID_SYNC();
        PH(14) { FRESH(); Gemm g{ya, Wb + WO_GLU, 512, 512, 0, 0, 512}; Order S; S.init(T, 512, 1, X.G, X.c); pg8::EpiGlu E{ya, P->in[I_BGLU] + (size_t)l * SW, yg};
          pg8::gemm_phase<pg8::EpiGlu, false>(X.lds, g, S, E, X.tid); }
        GRID_SYNC();
        if ((512 % X.G) == 0) {
        PH(15) { FRESH(); Gemm g{yg, Wb + WO_A, 512, 512, (size_t)(WS_O - WS_YG) / 2, (size_t)(WO_B - WO_A), 512}; Order S; S.init(T, 1024, 2, X.G, X.c); pg8::EpiMerge2 E{gates, Hb};
          pg8::gemm_phase<pg8::EpiMerge2, false>(X.lds, g, S, E, X.tid); }
        } else {
        PH(15) { FRESH(); Gemm g{yg, Wb + WO_A, 512, 512, 0, 0, 512}; Order S; S.init(T, 1024, 1, X.G, X.c); pg8::EpiMerge<false> E{gates, 0, Hb};
          pg8::gemm_phase<pg8::EpiMerge<false>, false>(X.lds, g, S, E, X.tid); }
        GRID_SYNC();
        PH(16) { FRESH(); Gemm g{Ob, Wb + WO_B, 512, 512, 0, 0, 512}; Order S; S.init(T, 1024, 1, X.G, X.c); pg8::EpiMerge<true> E{gates, 1024, Hb};
          pg8::gemm_phase<pg8::EpiMerge<true>, false>(X.lds, g, S, E, X.tid); }
        }
        GRID_SYNC();
        PH(17) { FRESH(); Gemm g{Hb, Wb + WO_OUT, 1024, 1024, 0, 0, 1024}; Order S; S.init(T, 1024, 1, X.G, X.c); pg8::EpiRes E{xin, P->out, modl + 2048};
          pg8::gemm_phase<pg8::EpiRes, false>(X.lds, g, S, E, X.tid); }
        GRID_SYNC();
        PH(18) { FRESH(); norm_phase(X, P->out, P->in[I_N2G] + (size_t)l * 1024, modl + 3072, modl + 4096, Hb); }
        GRID_SYNC();
        PH(19) { FRESH(); Gemm g{Hb, Wb + WO_GU, 1024, 1024, 0, 0, 1024}; Order S; S.init(T, 5632, 1, X.G, X.c); pg8::EpiGU E{hid};
          pg8::gemm_phase<pg8::EpiGU, false>(X.lds, g, S, E, X.tid); }
        GRID_SYNC();
        PH(20) { FRESH(); Gemm g{hid, Wb + WO_DOWN, DFF, DFF, 0, 0, DFF}; Order S; S.init(T, 1024, 1, X.G, X.c); pg8::EpiRes E{P->out, P->out, modl + 5120};
          pg8::gemm_phase<pg8::EpiRes, false>(X.lds, g, S, E, X.tid); }
        GRID_SYNC();
    }
    PH(21) { FRESH(); final_norm_phase(X, P->out, P->in[I_FING]); }
#ifdef PROBE_PHASE
    GRID_SYNC(); if (blockIdx.x == 0 && X.tid == 0) P->out[0] = PROBE_Q * (float)(int)((float)probe_acc * 0.01f / PROBE_Q + 0.5f);
#endif
}

extern "C" void kernel_launch(void* const* d_in, const int* in_sizes, int n_in, void* d_out, int out_size, void* d_ws, size_t ws_size, hipStream_t stream) {
    static int grid_blocks = 0;
    if (grid_blocks == 0) {
        if (n_in != 30 || ws_size < WS_END) { fprintf(stderr, "kernel_launch: unexpected n_in %d / ws_size %zu (need %zu)\n", n_in, ws_size, (size_t)WS_END); grid_blocks = -1; return; }
        int dev = 0, cus = 0, per_cu = 0;
        hipGetDevice(&dev);
        hipDeviceGetAttribute(&cus, hipDeviceAttributeMultiprocessorCount, dev);
        if (hipFuncSetAttribute((const void*)trunk_fwd, hipFuncAttributeMaxDynamicSharedMemorySize, LDS_BYTES) != hipSuccess) fprintf(stderr, "kernel_launch: hipFuncSetAttribute failed\n");
        hipOccupancyMaxActiveBlocksPerMultiprocessor(&per_cu, (const void*)trunk_fwd, NTHR, LDS_BYTES);
        if (per_cu < 1) per_cu = 1;
        grid_blocks = cus * per_cu;
        fprintf(stderr, "kernel_launch: cus %d per_cu %d grid %d\n", cus, per_cu, grid_blocks);
    }
    if (grid_blocks < 0) return;
    if (hipMemsetAsync((char*)d_ws + WS_BAR, 0, 16384, stream) != hipSuccess) fprintf(stderr, "kernel_launch: memset failed\n");
    Params p{};
    for (int i = 0; i < 30; ++i) p.in[i] = (const float*)d_in[i];
    p.out = (float*)d_out; p.ws = (unsigned char*)d_ws;
    void* args[] = {&p};
    hipError_t e = hipLaunchCooperativeKernel((const void*)trunk_fwd, dim3(grid_blocks), dim3(NTHR), args, LDS_BYTES, stream);
    if (e != hipSuccess) fprintf(stderr, "cooperative launch failed: %s (grid %d)\n", hipGetErrorString(e), grid_blocks);
}
```

```cpp
#include <hip/hip_runtime.h>
#include <hip/hip_cooperative_groups.h>
#include <cstdio>
#include <cstdint>
#include <cstddef>
namespace cg = cooperative_groups;

#define LAS __attribute__((address_space(3)))
typedef unsigned short bf16_t;
typedef short bf16x8 __attribute__((ext_vector_type(8)));
typedef short s16x4 __attribute__((ext_vector_type(4)));
typedef float f32x4 __attribute__((ext_vector_type(4)));
typedef float f32x2 __attribute__((ext_vector_type(2)));
typedef float f32x16 __attribute__((ext_vector_type(16)));
typedef unsigned u32x4 __attribute__((ext_vector_type(4)));
typedef unsigned u32x2 __attribute__((ext_vector_type(2)));
typedef int i32x4 __attribute__((ext_vector_type(4)));

constexpr int D = 1024, BATCH = 2, SEQ = 16384, T = BATCH * SEQ, DEPTH = 4;
constexpr int SW = 512, NG = 32, SP = 64;
constexpr int NH = 8, QKD = 96, QL = 256, KVL = 128;
constexpr int DFF = 2816, INC = 2976;
constexpr int NCH = T / 64;
constexpr float EPS = 1e-6f;

constexpr size_t MiB = 1u << 20;
constexpr size_t WS_MOD = 0, WS_TPOS = 1 * MiB, WS_ROPE = 2 * MiB, WS_APOW = 6 * MiB, WS_BBAR = 8 * MiB, WS_KG = 9 * MiB, WS_ET = 11 * MiB, WS_FT = 19 * MiB,
                 WS_S = 28 * MiB, WS_HC = 36 * MiB, WS_W = 40 * MiB, WS_H = 68 * MiB, WS_UG = 132 * MiB, WS_ZX = 164 * MiB, WS_GATES = 196 * MiB, WS_Q = 324 * MiB,
                 WS_KN = 372 * MiB, WS_KPE = 404 * MiB, WS_VT = 406 * MiB, WS_O = 438 * MiB, WS_YPART = 470 * MiB, WS_END = 502 * MiB;
constexpr size_t WS_BAR = 1 * MiB + 65536;
constexpr size_t WS_YA = WS_ZX, WS_YG = WS_Q, WS_HID = WS_GATES;
constexpr size_t WO_IN = 0, WO_GLU = WO_IN + 3072 * 1024, WO_A = WO_GLU + 512 * 512, WO_B = WO_A + 1024 * 512, WO_UQ = WO_B + 1024 * 512, WO_UK = WO_UQ + 768 * 256,
                 WO_UV = WO_UK + 512 * 128, WO_OUT = WO_UV + 512 * 128, WO_GU = WO_OUT + 1024 * 1024, WO_DOWN = WO_GU + 5632 * 1024, WO_END = WO_DOWN + 1024 * 2816;
static_assert(WO_END * 2 <= 28 * MiB, "weight region");

struct Params {
    const float* in[30];
    float* out;
    unsigned char* ws;
};

typedef __bf16 bf16x2_t __attribute__((ext_vector_type(2)));
__device__ __forceinline__ unsigned cvt_pk_bf16(float lo, float hi) { f32x2 v = {lo, hi}; bf16x2_t b = __builtin_convertvector(v, bf16x2_t); return __builtin_bit_cast(unsigned, b); }
__device__ __forceinline__ bf16_t f2bf(float f) { unsigned u = __builtin_bit_cast(unsigned, f); return (bf16_t)((u + 0x7fffu + ((u >> 16) & 1u)) >> 16); }
__device__ __forceinline__ float bf2f(unsigned short h) { return __builtin_bit_cast(float, (unsigned)h << 16); }
__device__ __forceinline__ float bflo(unsigned w) { return __builtin_bit_cast(float, w << 16); }
__device__ __forceinline__ float bfhi(unsigned w) { return __builtin_bit_cast(float, w & 0xffff0000u); }
__device__ __forceinline__ float sigmoidf_(float x) { return __builtin_amdgcn_rcpf(1.0f + __expf(-x)); }
__device__ __forceinline__ float gelu_tanh(float x) { const float z = 1.5957691216f * (x + 0.044715f * x * x * x); return x * sigmoidf_(z); }
__device__ __forceinline__ u32x4 pack8(const f32x4 a, const f32x4 b) { u32x4 w; w.x = cvt_pk_bf16(a[0], a[1]); w.y = cvt_pk_bf16(a[2], a[3]); w.z = cvt_pk_bf16(b[0], b[1]); w.w = cvt_pk_bf16(b[2], b[3]); return w; }
__device__ __forceinline__ void unpack8(const u32x4 w, f32x4& a, f32x4& b) { a = (f32x4){bflo(w.x), bfhi(w.x), bflo(w.y), bfhi(w.y)}; b = (f32x4){bflo(w.z), bfhi(w.z), bflo(w.w), bfhi(w.w)}; }
__device__ __forceinline__ float shflx(float v, int o, int lane) { return __builtin_bit_cast(float, __builtin_amdgcn_ds_bpermute((lane ^ o) << 2, __builtin_bit_cast(int, v))); }
__device__ __forceinline__ int shflxi(int v, int o, int lane) { return __builtin_amdgcn_ds_bpermute((lane ^ o) << 2, v); }
__device__ __forceinline__ float wave_sum(float v, int lane) {
#pragma unroll
    for (int o = 1; o < 64; o <<= 1) v += shflx(v, o, lane);
    return v;
}

namespace pg8 {
constexpr int BM = 256, BK = 64, HALF = 128, HTB = HALF * BK * 2, STAGE_BYTES = 8 * HTB, NXCD = 8, WGM = 8;
__device__ __forceinline__ int lds_byte(int r, int c) { const int st = (r >> 4) * 2 + (c >> 5), rr = r & 15, cc = c & 31, ob = rr * 64 + cc * 2; return st * 1024 + (ob ^ (((ob >> 9) & 1) << 5)); }
__device__ __forceinline__ void stage_rc(int b, int& R, int& C) { const int st = b / 1024, sb = b % 1024, swz = sb ^ (((sb >> 9) & 1) << 5); R = (st >> 1) * 16 + swz / 64; C = (st & 1) * 32 + (swz % 64) / 2; }
__device__ __forceinline__ int perm32(int rho) { const int n = rho >> 4, i = rho & 15; return 8 * (i >> 2) + 4 * n + (i & 3); }

struct Unit { int g, pm, pn; };
struct Gemm { const bf16_t* A; const bf16_t* Bt; int lda, ldb; size_t gsA, gsB; int K; };

struct Order {
    int nM, nN, per, total, G, c;
    __device__ void init(int M, int N, int groups, int G_, int c_) { nM = M / BM; nN = N / BM; per = nM * nN; total = per * groups; G = G_; c = c_; }
    __device__ bool next(int i, Unit& u) const {
        const int L = i * G + c; if (L >= total) return false;
        const int grp = L / per; int wgid = L - grp * per;
        { const int q = per / NXCD, r = per % NXCD, xcd = wgid % NXCD, off = wgid / NXCD; wgid = (xcd < r ? xcd * (q + 1) : r * (q + 1) + (xcd - r) * q) + off; }
        const int nig = WGM * nN, gid = wgid / nig, fm = gid * WGM, gsz = (nM - fm) < WGM ? (nM - fm) : WGM;
        u.g = grp; u.pm = fm + ((wgid % nig) % gsz); u.pn = (wgid % nig) / gsz; return true;
    }
};

template <class Epi, bool TOEP>
__device__ __forceinline__ void gemm_phase(LAS unsigned char* lds, const Gemm g, const Order& S, const Epi& E, int tid_in) {
    int tid_ = tid_in; asm volatile("" : "+v"(tid_));
    const int tid = tid_, wid = __builtin_amdgcn_readfirstlane(tid >> 6), lane = tid & 63, wr = wid >> 2, wc = wid & 3, fr = lane & 15, fq = lane >> 4;
    const int K = g.K, nt = K / BK;
    unsigned voffA[2], voffB[2];
#pragma unroll
    for (int i = 0; i < 2; ++i) { int R, C; stage_rc(tid * 16 + i * 8192, R, C); const int Rb = (R & ~31) + perm32(R & 31);
        voffA[i] = (unsigned)(R * g.lda + C) * 2u; voffB[i] = TOEP ? (unsigned)(Rb * g.ldb + (C & 15) - (C >> 4) * 256 + 768) * 2u : (unsigned)(Rb * g.ldb + C) * 2u; }
    const ptrdiff_t kstepA = (ptrdiff_t)(BK * 2), kstepB = TOEP ? (ptrdiff_t)-2048 : (ptrdiff_t)(BK * 2);
    const ptrdiff_t hstepA = (ptrdiff_t)HALF * g.lda * 2, hstepB = (ptrdiff_t)HALF * g.ldb * 2;
    const unsigned ldsb = (unsigned)(size_t)lds + (unsigned)wid * 1024u;
    const int aoff = lds_byte(wr * 64 + fr, fq * 8), boff = lds_byte(wc * 32 + fr, fq * 8);
#define PG8_UA(u) ((const char*)g.A + ((size_t)(u).g * g.gsA + (size_t)(u).pm * BM * g.lda) * 2)
#define PG8_UB(u) ((const char*)g.Bt + ((size_t)(u).g * g.gsB + (size_t)(u).pn * BM * g.ldb) * 2 - (TOEP ? 1536 : 0))
#define PG8_SA(b, h) (((b) * 2 + (h)) * HTB)
#define PG8_SB(b, h) ((4 + (b) * 2 + (h)) * HTB)
#define PG8_STAGE(bufoff, gbase, voff) do { _Pragma("unroll") for (int _i = 0; _i < 2; ++_i) { unsigned keep_; \
        asm volatile("s_mov_b32 %0, m0\n\ts_mov_b32 m0, %3\n\ts_nop 0\n\tglobal_load_lds_dwordx4 %1, %2\n\ts_mov_b32 m0, %0" : "=&s"(keep_) : "v"((voff)[_i]), "s"((const char*)(gbase)), "s"(ldsb + (unsigned)((bufoff) + _i * 8192)) : "memory"); } } while (0)
#define PG8_LDA(dst, b, h) do { _Pragma("unroll") for (int m = 0; m < 4; ++m) _Pragma("unroll") for (int k = 0; k < 2; ++k) dst[m][k] = *(const LAS bf16x8*)(lds + PG8_SA(b, h) + aoff + m * 2048 + k * 1024); } while (0)
#define PG8_LDB(dst, b, h) do { _Pragma("unroll") for (int n = 0; n < 2; ++n) _Pragma("unroll") for (int k = 0; k < 2; ++k) dst[n][k] = *(const LAS bf16x8*)(lds + PG8_SB(b, h) + boff + n * 2048 + k * 1024); } while (0)
#define PG8_MMA(ai, bj, At, Bt) do { __builtin_amdgcn_s_setprio(1); _Pragma("unroll") for (int m = 0; m < 4; ++m) _Pragma("unroll") for (int n = 0; n < 2; ++n) _Pragma("unroll") for (int k = 0; k < 2; ++k) \
        acc[ai][bj][m][n] = __builtin_amdgcn_mfma_f32_16x16x32_bf16(Bt[n][k], At[m][k], acc[ai][bj][m][n], 0, 0, 0); __builtin_amdgcn_s_setprio(0); } while (0)
#define PG8_WAIT_V(n) asm volatile("s_waitcnt vmcnt(" #n ")" ::: "memory")
#define PG8_WAIT_L(n) asm volatile("s_waitcnt lgkmcnt(" #n ")" ::: "memory")
#define PG8_BAR __builtin_amdgcn_s_barrier()
#define PG8_SCHED __builtin_amdgcn_sched_barrier(0)
    Unit cur, nxt; int ui = 0;
    if (!S.next(0, cur)) return;
    f32x4 acc[2][2][4][2];
#pragma unroll
    for (int a = 0; a < 2; ++a)
#pragma unroll
        for (int b = 0; b < 2; ++b)
#pragma unroll
            for (int m = 0; m < 4; ++m)
#pragma unroll
                for (int n = 0; n < 2; ++n) acc[a][b][m][n] = (f32x4){0.f, 0.f, 0.f, 0.f};
    bf16x8 At[4][2], B0[2][2], B1[2][2];
    const char* cA = PG8_UA(cur); const char* cB = PG8_UB(cur);
    PG8_STAGE(PG8_SB(0, 0), cB, voffB); PG8_STAGE(PG8_SB(0, 1), cB + hstepB, voffB); PG8_STAGE(PG8_SA(0, 0), cA, voffA); PG8_STAGE(PG8_SA(0, 1), cA + hstepA, voffA);
    if (wr == 1) PG8_BAR;
    PG8_WAIT_V(2); PG8_BAR;
    PG8_STAGE(PG8_SB(1, 0), cB + kstepB, voffB); PG8_STAGE(PG8_SA(1, 0), cA + kstepA, voffA); PG8_STAGE(PG8_SB(1, 1), cB + hstepB + kstepB, voffB);
    PG8_WAIT_V(6); PG8_BAR;
    for (;;) {
        const bool has_next = S.next(ui + 1, nxt);
        const char* nA = has_next ? PG8_UA(nxt) : cA; const char* nB = has_next ? PG8_UB(nxt) : cB;
        for (int t = 0; t < nt; t += 2) {
            const bool last = (t == nt - 2);
            asm volatile("" : "+v"(voffA[0]), "+v"(voffA[1]), "+v"(voffB[0]), "+v"(voffB[1]));
            const char* a1 = cA + (ptrdiff_t)(t + 1) * kstepA;
            const char* a2 = last ? nA : cA + (ptrdiff_t)(t + 2) * kstepA; const char* b2 = last ? nB : cB + (ptrdiff_t)(t + 2) * kstepB;
            const char* a3 = a2 + kstepA; const char* b3 = b2 + kstepB;
            PG8_LDB(B0, 0, 0); PG8_LDB(B1, 0, 1); PG8_SCHED; PG8_LDA(At, 0, 0); PG8_STAGE(PG8_SA(1, 1), a1 + hstepA, voffA);
            PG8_WAIT_V(8); PG8_WAIT_L(0); PG8_BAR; PG8_MMA(0, 0, At, B0); PG8_MMA(0, 1, At, B1); PG8_BAR; PG8_SCHED;
            PG8_LDA(At, 0, 1); PG8_STAGE(PG8_SB(0, 0), b2, voffB); PG8_STAGE(PG8_SB(0, 1), b2 + hstepB, voffB); PG8_STAGE(PG8_SA(0, 0), a2, voffA);
            PG8_WAIT_V(8); PG8_WAIT_L(0); PG8_BAR; PG8_MMA(1, 0, At, B0); PG8_MMA(1, 1, At, B1); PG8_BAR; PG8_SCHED;
            PG8_LDB(B0, 1, 0); PG8_LDB(B1, 1, 1); PG8_SCHED; PG8_LDA(At, 1, 0); PG8_STAGE(PG8_SA(0, 1), a2 + hstepA, voffA);
            PG8_WAIT_V(8); PG8_WAIT_L(0); PG8_BAR; PG8_MMA(0, 0, At, B0); PG8_MMA(0, 1, At, B1); PG8_BAR; PG8_SCHED;
            PG8_LDA(At, 1, 1); PG8_STAGE(PG8_SB(1, 0), b3, voffB); PG8_STAGE(PG8_SB(1, 1), b3 + hstepB, voffB); PG8_STAGE(PG8_SA(1, 0), a3, voffA);
            PG8_WAIT_V(8); PG8_WAIT_L(0); PG8_BAR; PG8_MMA(1, 0, At, B0); PG8_MMA(1, 1, At, B1); PG8_BAR; PG8_SCHED;
        }
        if (wr == 0) PG8_BAR;
        { int frx = fr, fqx = fq; asm volatile("" : "+v"(frx), "+v"(fqx)); E(acc, cur, wr, wc, frx, fqx); }
        if (!has_next) break;
#pragma unroll
        for (int a = 0; a < 2; ++a)
#pragma unroll
            for (int b = 0; b < 2; ++b)
#pragma unroll
                for (int m = 0; m < 4; ++m)
#pragma unroll
                    for (int n = 0; n < 2; ++n) acc[a][b][m][n] = (f32x4){0.f, 0.f, 0.f, 0.f};
        cur = nxt; cA = nA; cB = nB; ++ui;
        if (wr == 1) PG8_BAR;
    }
    PG8_WAIT_V(0);
    PG8_BAR;
#undef PG8_UA
#undef PG8_UB
#undef PG8_SA
#undef PG8_SB
#undef PG8_STAGE
#undef PG8_LDA
#undef PG8_LDB
#undef PG8_MMA
#undef PG8_WAIT_V
#undef PG8_WAIT_L
#undef PG8_BAR
#undef PG8_SCHED
}

#define EPI_BEGIN \
    _Pragma("unroll") for (int ai = 0; ai < 2; ++ai) _Pragma("unroll") for (int m = 0; m < 4; ++m) { \
        const int row = u.pm * 256 + ai * 128 + wr * 64 + m * 16 + fr; \
        _Pragma("unroll") for (int bj = 0; bj < 2; ++bj) { \
            const int col = u.pn * 256 + bj * 128 + wc * 32 + 8 * fq; \
            f32x4 v0 = acc[ai][bj][m][0], v1 = acc[ai][bj][m][1];
#define EPI_END } if (m == 3) asm volatile("" ::: "memory"); }
#define EPI_SIG const f32x4 (&acc)[2][2][4][2], const Unit& u, int wr, int wc, int fr, int fq

struct EpiStore { bf16_t* O; size_t gs; int ldc;
    __device__ __forceinline__ void operator()(EPI_SIG) const {
        EPI_BEGIN *(u32x4*)(O + (size_t)u.g * gs + (size_t)row * ldc + col) = pack8(v0, v1); EPI_END } };
struct EpiIn { bf16_t* Ug; bf16_t* zx; bf16_t* gates; bf16_t* Kpe; const float* qg; const float* kg; const float* cosT; const float* sinT; LAS unsigned char* lds;
    __device__ __forceinline__ void operator()(EPI_SIG) const {
        if (u.pn < 2) { EPI_BEGIN *(u32x4*)(Ug + ((size_t)((col >> 4) * NCH + (row >> 6)) * 1024 + (row & 63) * 16 + (col & 15))) = pack8(v0, v1); EPI_END }
        else if (u.pn < 4) {
            const bool isq = (u.pn == 2); const int lane = fr + 16 * fq;
            LAS float* red = (LAS float*)(lds + 131072 + 1024);
#pragma unroll
            for (int ai = 0; ai < 2; ++ai)
#pragma unroll
                for (int m = 0; m < 4; ++m) { float p = 0.f;
#pragma unroll
                    for (int bj = 0; bj < 2; ++bj) if (isq || bj == 0) { const f32x4 a = acc[ai][bj][m][0], b = acc[ai][bj][m][1];
                        p += (a[0] * a[0] + a[1] * a[1]) + (a[2] * a[2] + a[3] * a[3]) + (b[0] * b[0] + b[1] * b[1]) + (b[2] * b[2] + b[3] * b[3]); }
                    p += shflx(p, 16, lane); p += shflx(p, 32, lane);
                    if (fq == 0) red[(ai * 128 + wr * 64 + m * 16 + fr) * 4 + wc] = p; }
            asm volatile("s_waitcnt lgkmcnt(0)" ::: "memory"); __builtin_amdgcn_s_barrier(); asm volatile("" ::: "memory");
            const float invn = isq ? (1.0f / 256.0f) : (1.0f / 128.0f);
#pragma unroll
            for (int ai = 0; ai < 2; ++ai)
#pragma unroll
                for (int m = 0; m < 4; ++m) { const int rl = ai * 128 + wr * 64 + m * 16 + fr, row = u.pm * 256 + rl;
                    const f32x4 ps = *(const LAS f32x4*)(red + rl * 4); const float r = rsqrtf(((ps[0] + ps[1]) + (ps[2] + ps[3])) * invn + EPS);
#pragma unroll
                    for (int bj = 0; bj < 2; ++bj) { const int cl = bj * 128 + wc * 32 + 8 * fq; f32x4 v0 = acc[ai][bj][m][0], v1 = acc[ai][bj][m][1];
                        if (isq || bj == 0) { const float* gp = isq ? qg + cl : kg + cl; const f32x4 g0 = *(const f32x4*)gp, g1 = *(const f32x4*)(gp + 4);
                            v0 = v0 * r * g0; v1 = v1 * r * g1; *(u32x4*)(zx + (size_t)row * 512 + (isq ? 0 : 256) + cl) = pack8(v0, v1); }
                        else if (wc == 0) { const int i0 = 4 * fq; const f32x4 c4 = *(const f32x4*)(cosT + (size_t)row * 16 + i0), s4 = *(const f32x4*)(sinT + (size_t)row * 16 + i0);
                            f32x4 o0, o1;
                            o0[0] = v0[0] * c4[0] - v0[1] * s4[0]; o0[1] = v0[1] * c4[0] + v0[0] * s4[0]; o0[2] = v0[2] * c4[1] - v0[3] * s4[1]; o0[3] = v0[3] * c4[1] + v0[2] * s4[1];
                            o1[0] = v1[0] * c4[2] - v1[1] * s4[2]; o1[1] = v1[1] * c4[2] + v1[0] * s4[2]; o1[2] = v1[2] * c4[3] - v1[3] * s4[3]; o1[3] = v1[3] * c4[3] + v1[2] * s4[3];
                            *(u32x4*)(Kpe + (size_t)row * 32 + 8 * fq) = pack8(o0, o1); } } }
            asm volatile("s_waitcnt lgkmcnt(0)" ::: "memory"); __builtin_amdgcn_s_barrier(); asm volatile("" ::: "memory");
        }
        else { EPI_BEGIN
#pragma unroll
            for (int i = 0; i < 4; ++i) { v0[i] = sigmoidf_(v0[i]); v1[i] = sigmoidf_(v1[i]); }
            *(u32x4*)(gates + (size_t)row * 2048 + (col - 1024)) = pack8(v0, v1); EPI_END } } };
struct EpiQ { bf16_t* Q; const float* cosT; const float* sinT; float scale;
    __device__ __forceinline__ void operator()(EPI_SIG) const {
        EPI_BEGIN
            const int head = col / 96, d = col - head * 96;
            v0 = v0 * scale; v1 = v1 * scale;
            if (d >= 64) { const int i0 = (d - 64) >> 1; const f32x4 c4 = *(const f32x4*)(cosT + (size_t)row * 16 + i0), s4 = *(const f32x4*)(sinT + (size_t)row * 16 + i0);
                const f32x4 a = v0, b = v1;
                v0[0] = a[0] * c4[0] - a[1] * s4[0]; v0[1] = a[1] * c4[0] + a[0] * s4[0]; v0[2] = a[2] * c4[1] - a[3] * s4[1]; v0[3] = a[3] * c4[1] + a[2] * s4[1];
                v1[0] = b[0] * c4[2] - b[1] * s4[2]; v1[1] = b[1] * c4[2] + b[0] * s4[2]; v1[2] = b[2] * c4[3] - b[3] * s4[3]; v1[3] = b[3] * c4[3] + b[2] * s4[3]; }
            *(u32x4*)(Q + (size_t)row * 768 + col) = pack8(v0, v1);
        EPI_END } };
struct EpiS { float* S;
    __device__ __forceinline__ void operator()(EPI_SIG) const {
        EPI_BEGIN if (bj == 0) { float* p = S + ((size_t)u.g * NCH + row) * 128 + col; *(f32x4*)p = v0; *(f32x4*)(p + 4) = v1; } EPI_END } };
struct EpiE { const bf16_t* ypart; const bf16_t* Ug; const float* dskip; bf16_t* ya;
    __device__ __forceinline__ void operator()(EPI_SIG) const {
        EPI_BEGIN
            const size_t off = ((size_t)u.g * NCH + row) * 1024 + col;
            f32x4 p0, p1, u0, u1; unpack8(*(const u32x4*)(ypart + off), p0, p1); unpack8(*(const u32x4*)(Ug + off), u0, u1);
            const float* dp = dskip + u.g * 16 + (col & 15); const f32x4 d0 = *(const f32x4*)dp, d1 = *(const f32x4*)(dp + 4);
            v0 = v0 + p0 + d0 * u0; v1 = v1 + p1 + d1 * u1;
#pragma unroll
            for (int i = 0; i < 4; ++i) { v0[i] = gelu_tanh(v0[i]); v1[i] = gelu_tanh(v1[i]); }
            *(u32x4*)(ya + ((size_t)row * 64 + (col >> 4)) * 512 + u.g * 16 + (col & 15)) = pack8(v0, v1);
        EPI_END } };
struct EpiGlu { const bf16_t* ya; const float* bias; bf16_t* yg;
    __device__ __forceinline__ void operator()(EPI_SIG) const {
        EPI_BEGIN
            f32x4 y0, y1; unpack8(*(const u32x4*)(ya + (size_t)row * 512 + col), y0, y1);
            const f32x4 b0 = *(const f32x4*)(bias + col), b1 = *(const f32x4*)(bias + col + 4);
#pragma unroll
            for (int i = 0; i < 4; ++i) { v0[i] = y0[i] * sigmoidf_(v0[i] + b0[i]); v1[i] = y1[i] * sigmoidf_(v1[i] + b1[i]); }
            *(u32x4*)(yg + (size_t)row * 512 + col) = pack8(v0, v1);
        EPI_END } };
template <bool ACCUM> struct EpiMerge { const bf16_t* gates; int goff; bf16_t* mg;
    __device__ __forceinline__ void operator()(EPI_SIG) const {
        EPI_BEGIN
            f32x4 g0, g1; unpack8(*(const u32x4*)(gates + (size_t)row * 2048 + goff + col), g0, g1);
            v0 = v0 * g0; v1 = v1 * g1;
            if (ACCUM) { f32x4 o0, o1; unpack8(*(const u32x4*)(mg + (size_t)row * 1024 + col), o0, o1); v0 = v0 + o0; v1 = v1 + o1; }
            *(u32x4*)(mg + (size_t)row * 1024 + col) = pack8(v0, v1);
        EPI_END } };
struct EpiMerge2 { const bf16_t* gates; bf16_t* mg;
    __device__ __forceinline__ void operator()(EPI_SIG) const {
        if (u.g == 0) { EpiMerge<false> e{gates, 0, mg}; e(acc, u, wr, wc, fr, fq); } else { EpiMerge<true> e{gates, 1024, mg}; e(acc, u, wr, wc, fr, fq); } } };
struct EpiRes { const float* xin; float* xout; const float* gmod;
    __device__ __forceinline__ void operator()(EPI_SIG) const {
        EPI_BEGIN
            const float* gp = gmod + (row >= SEQ ? 6144 : 0) + col; const f32x4 g0 = *(const f32x4*)gp, g1 = *(const f32x4*)(gp + 4);
            const float* xp = xin + (size_t)row * 1024 + col; float* op = xout + (size_t)row * 1024 + col;
            const f32x4 x0 = *(const f32x4*)xp, x1 = *(const f32x4*)(xp + 4);
            *(f32x4*)op = x0 + g0 * v0; *(f32x4*)(op + 4) = x1 + g1 * v1;
        EPI_END } };
struct EpiGU { bf16_t* hid;
    __device__ __forceinline__ void operator()(EPI_SIG) const {
        EPI_BEGIN
#pragma unroll
            for (int i = 0; i < 4; ++i) v0[i] = v0[i] * sigmoidf_(v0[i]) * v1[i];
            u32x2 w; w.x = cvt_pk_bf16(v0[0], v0[1]); w.y = cvt_pk_bf16(v0[2], v0[3]);
            *(u32x2*)(hid + (size_t)row * DFF + (col >> 1)) = w;
        EPI_END } };
}

namespace att {
constexpr int KSTR = 208, VSTR = 144, KBUF = 64 * KSTR, VBUF = 64 * VSTR, OFF_V = 3 * KBUF, OFF_P = OFF_V + 3 * VBUF, LDS_BYTES = OFF_P + 768;
constexpr float NEG = -1.0e30f;

__device__ __forceinline__ void phase(LAS unsigned char* lds, const bf16_t* __restrict__ Q, const bf16_t* __restrict__ Kn, const bf16_t* __restrict__ Kpe, const bf16_t* __restrict__ Vt,
                                      bf16_t* __restrict__ O, const int* __restrict__ pos, const int* __restrict__ tmin, const int* __restrict__ tmax, int G, int c, int tid_in) {
    int tid_ = tid_in; asm volatile("" : "+v"(tid_));
    const int tid = tid_, wave = __builtin_amdgcn_readfirstlane(tid >> 6), lane = tid & 63, q32 = lane & 31, hi = lane >> 5;
    for (int ui = c; ui < 1024; ui += G) {
        const int rnd = ui >> 8, c8 = ui & 255, cc = (G == 256) ? ((2 * (c8 & 7) + (c8 >> 7)) * 16 + ((c8 >> 3) & 15)) : c8, bh = cc >> 4, j16 = cc & 15;
        const int qb = rnd == 0 ? 63 - j16 : rnd == 1 ? 32 + j16 : rnd == 2 ? 31 - j16 : j16;
        const int b = bh >> 3, h = bh & 7;
        const int* tmn = tmin + b * 256; const int* tmx = tmax + b * 256;
        int qmax = tmx[qb * 4], qmin = tmn[qb * 4];
#pragma unroll
        for (int i = 1; i < 4; ++i) { qmax = max(qmax, tmx[qb * 4 + i]); qmin = min(qmin, tmn[qb * 4 + i]); }
        const size_t tok0 = (size_t)b * SEQ;
        const size_t qrow = tok0 + qb * 256 + wave * 32 + q32;
        bf16x8 qf[6];
        { const bf16_t* qp = Q + qrow * 768 + h * 96 + 8 * hi;
#pragma unroll
          for (int j = 0; j < 6; ++j) qf[j] = *(const bf16x8*)(qp + 16 * j); }
        const int posq = pos[qrow];
        f32x16 o0, o1;
#pragma unroll
        for (int r = 0; r < 16; ++r) { o0[r] = 0.f; o1[r] = 0.f; }
        float mrun = NEG, lrun = 0.f;
        const int krow = tid >> 3, kpc = tid & 7, prow = (tid & 255) >> 2, ppc = tid & 3;
        const bf16_t* kn_src = Kn + (tok0 + krow) * 512 + h * 64 + kpc * 8;
        const bf16_t* kp_src = Kpe + (tok0 + prow) * 32 + ppc * 8;
        const bf16_t* vt_src = Vt + (size_t)(h * 64 + krow) * T + tok0 + kpc * 8;
        const int* ps_src = pos + tok0 + (tid & 63);
        unsigned long long vm[4], mm[4];
#pragma unroll
        for (int i = 0; i < 4; ++i) { const int a_ = tmn[lane + 64 * i], b_ = tmx[lane + 64 * i]; vm[i] = __builtin_amdgcn_ballot_w64(a_ <= qmax); mm[i] = __builtin_amdgcn_ballot_w64(b_ > qmin); }
        int it_w = 0; unsigned long long it_c = vm[0], it_m = mm[0];
#define ATT_ITER(res_) do { \
            while (it_c == 0ull && it_w < 3) { ++it_w; it_c = it_w == 1 ? vm[1] : it_w == 2 ? vm[2] : vm[3]; it_m = it_w == 1 ? mm[1] : it_w == 2 ? mm[2] : mm[3]; } \
            if (it_c == 0ull) res_ = 256; \
            else { const int b_ = (int)__builtin_ctzll(it_c); res_ = 64 * it_w + b_ + (int)((it_m >> b_) & 1ull) * 512; it_c &= it_c - 1ull; } } while (0)
        u32x4 rkA, rpA, rvA, rkB, rpB, rvB; int rposA = 0, rposB = 0;
        rpA = (u32x4){0u, 0u, 0u, 0u}; rpB = rpA;
#define ATT_LOAD(S, kt_) do { rk##S = *(const u32x4*)(kn_src + (size_t)(kt_) * 64 * 512); if (tid < 256) rp##S = *(const u32x4*)(kp_src + (size_t)(kt_) * 64 * 32); \
        rv##S = *(const u32x4*)(vt_src + (size_t)(kt_) * 64); if (tid < 64) rpos##S = ps_src[(kt_) * 64]; } while (0)
#define ATT_STORE(S, bf_) do { *(LAS u32x4*)(lds + (bf_) * KBUF + krow * KSTR + kpc * 16) = rk##S; if (tid < 256) *(LAS u32x4*)(lds + (bf_) * KBUF + prow * KSTR + 128 + ppc * 16) = rp##S; \
        LAS unsigned char* vp_ = lds + OFF_V + (bf_) * VBUF + krow * VSTR + (kpc >> 1) * 32 + (kpc & 1) * 8; *(LAS u32x2*)vp_ = (u32x2){rv##S.x, rv##S.y}; *(LAS u32x2*)(vp_ + 16) = (u32x2){rv##S.z, rv##S.w}; \
        if (tid < 64) *(LAS int*)(lds + OFF_P + (bf_) * 256 + tid * 4) = rpos##S; } while (0)
#define ATT_QK(bf_) do { \
            const LAS unsigned char* kb = lds + (bf_) * KBUF + q32 * KSTR + hi * 16; \
            bf16x8 kf0[6], kf1[6]; \
            _Pragma("unroll") for (int j = 0; j < 6; ++j) { kf0[j] = *(const LAS bf16x8*)(kb + j * 32); kf1[j] = *(const LAS bf16x8*)(kb + 32 * KSTR + j * 32); } \
            _Pragma("unroll") for (int r = 0; r < 16; ++r) { s0[r] = 0.f; s1[r] = 0.f; } \
            _Pragma("unroll") for (int j = 0; j < 6; ++j) { s0 = __builtin_amdgcn_mfma_f32_32x32x16_bf16(kf0[j], qf[j], s0, 0, 0, 0); s1 = __builtin_amdgcn_mfma_f32_32x32x16_bf16(kf1[j], qf[j], s1, 0, 0, 0); } \
        } while (0)
#define ATT_SM(bf_, kt_) do { \
            const bool need_mask = ((kt_) & 512) != 0; \
            if (need_mask) { \
                const LAS int* pp = (const LAS int*)(lds + OFF_P + (bf_) * 256) + 4 * hi; \
                _Pragma("unroll") for (int i = 0; i < 4; ++i) { \
                    const i32x4 p0 = *(const LAS i32x4*)(pp + 8 * i), p1 = *(const LAS i32x4*)(pp + 32 + 8 * i); \
                    _Pragma("unroll") for (int e = 0; e < 4; ++e) { if (p0[e] > posq) s0[4 * i + e] = NEG; if (p1[e] > posq) s1[4 * i + e] = NEG; } } } \
            float mx = __builtin_amdgcn_fmed3f(s0[0], s1[0], INFINITY); \
            _Pragma("unroll") for (int r = 1; r < 16; ++r) { mx = __builtin_amdgcn_fmed3f(mx, s0[r], INFINITY); mx = __builtin_amdgcn_fmed3f(mx, s1[r], INFINITY); } \
            mx = __builtin_amdgcn_fmed3f(mx, shflx(mx, 32, lane), INFINITY); \
            if (__builtin_amdgcn_ballot_w64(mx > mrun) != 0ull) { \
                const float mnew = fmaxf(mrun, mx); const float alpha = __builtin_amdgcn_exp2f(mrun - mnew); mrun = mnew; lrun *= alpha; \
                _Pragma("unroll") for (int r = 0; r < 16; ++r) { o0[r] *= alpha; o1[r] *= alpha; } } \
            { const f32x2 m2 = (f32x2){mrun, mrun}; f32x2 ls2 = (f32x2){0.f, 0.f}; \
              _Pragma("unroll") for (int r = 0; r < 16; r += 2) { \
                  f32x2 a_ = (f32x2){s0[r], s0[r + 1]} - m2, b_ = (f32x2){s1[r], s1[r + 1]} - m2; \
                  a_.x = __builtin_amdgcn_exp2f(a_.x); a_.y = __builtin_amdgcn_exp2f(a_.y); b_.x = __builtin_amdgcn_exp2f(b_.x); b_.y = __builtin_amdgcn_exp2f(b_.y); \
                  s0[r] = a_.x; s0[r + 1] = a_.y; s1[r] = b_.x; s1[r + 1] = b_.y; ls2 += a_; ls2 += b_; } \
              lrun += ls2.x + ls2.y; } \
            _Pragma("unroll") for (int jj = 0; jj < 2; ++jj) { \
                u32x4 w0, w1; \
                w0.x = cvt_pk_bf16(s0[8 * jj + 0], s0[8 * jj + 1]); w0.y = cvt_pk_bf16(s0[8 * jj + 2], s0[8 * jj + 3]); w0.z = cvt_pk_bf16(s0[8 * jj + 4], s0[8 * jj + 5]); w0.w = cvt_pk_bf16(s0[8 * jj + 6], s0[8 * jj + 7]); \
                w1.x = cvt_pk_bf16(s1[8 * jj + 0], s1[8 * jj + 1]); w1.y = cvt_pk_bf16(s1[8 * jj + 2], s1[8 * jj + 3]); w1.z = cvt_pk_bf16(s1[8 * jj + 4], s1[8 * jj + 5]); w1.w = cvt_pk_bf16(s1[8 * jj + 6], s1[8 * jj + 7]); \
                pb[0][jj] = __builtin_bit_cast(bf16x8, w0); pb[1][jj] = __builtin_bit_cast(bf16x8, w1); } \
        } while (0)
#define ATT_PV(bf_) do { \
            const LAS unsigned char* vb = lds + OFF_V + (bf_) * VBUF + q32 * VSTR + hi * 16; \
            bf16x8 vfa[4], vfb[4]; \
            _Pragma("unroll") for (int xj = 0; xj < 4; ++xj) { vfa[xj] = *(const LAS bf16x8*)(vb + 32 * xj); vfb[xj] = *(const LAS bf16x8*)(vb + 32 * VSTR + 32 * xj); } \
            _Pragma("unroll") for (int x = 0; x < 2; ++x) _Pragma("unroll") for (int jj = 0; jj < 2; ++jj) { \
                o0 = __builtin_amdgcn_mfma_f32_32x32x16_bf16(vfa[2 * x + jj], pb[x][jj], o0, 0, 0, 0); \
                o1 = __builtin_amdgcn_mfma_f32_32x32x16_bf16(vfb[2 * x + jj], pb[x][jj], o1, 0, 0, 0); } \
        } while (0)
        f32x16 s0, s1; bf16x8 pb[2][2];
        const bool lateg = (wave & 4) != 0;
        int cur, nxt, t2, st = 0, stp = 0; bool havep = false;
        ATT_ITER(cur); nxt = 256; if (cur != 256) ATT_ITER(nxt);
        if (cur != 256) { ATT_LOAD(A, (cur & 255)); ATT_STORE(A, 0); }
        if (nxt != 256) ATT_LOAD(B, (nxt & 255));
        __syncthreads();
        while (cur != 256) {
            { const int st1 = st == 2 ? 0 : st + 1;
              t2 = 256; if (nxt != 256) ATT_ITER(t2);
              if (t2 != 256) ATT_LOAD(A, (t2 & 255));
              if (lateg) { if (havep) ATT_PV(stp); ATT_QK(st); ATT_SM(st, cur); havep = true; stp = st; }
              else { ATT_QK(st); ATT_SM(st, cur); ATT_PV(st); }
              if (nxt != 256) ATT_STORE(B, st1);
              __syncthreads();
              cur = nxt; nxt = t2; st = st1; }
            if (cur == 256) break;
            { const int st1 = st == 2 ? 0 : st + 1;
              t2 = 256; if (nxt != 256) ATT_ITER(t2);
              if (t2 != 256) ATT_LOAD(B, (t2 & 255));
              if (lateg) { if (havep) ATT_PV(stp); ATT_QK(st); ATT_SM(st, cur); havep = true; stp = st; }
              else { ATT_QK(st); ATT_SM(st, cur); ATT_PV(st); }
              if (nxt != 256) ATT_STORE(A, st1);
              __syncthreads();
              cur = nxt; nxt = t2; st = st1; }
        }
        if (lateg && havep) ATT_PV(stp);
        __syncthreads();
        const float ltot = lrun + shflx(lrun, 32, lane);
        const float inv = 1.0f / ltot;
        bf16_t* op = O + qrow * 512 + h * 64 + 4 * hi;
#pragma unroll
        for (int i = 0; i < 4; ++i) {
            u32x2 w; w.x = cvt_pk_bf16(o0[4 * i] * inv, o0[4 * i + 1] * inv); w.y = cvt_pk_bf16(o0[4 * i + 2] * inv, o0[4 * i + 3] * inv);
            *(u32x2*)(op + 8 * i) = w;
            u32x2 w2; w2.x = cvt_pk_bf16(o1[4 * i] * inv, o1[4 * i + 1] * inv); w2.y = cvt_pk_bf16(o1[4 * i + 2] * inv, o1[4 * i + 3] * inv);
            *(u32x2*)(op + 32 + 8 * i) = w2; }
#undef ATT_LOAD
#undef ATT_STORE
#undef ATT_QK
#undef ATT_SM
#undef ATT_PV
#undef ATT_ITER
    }
}
}


constexpr int NWAVES = 8, NTHR = 512;
constexpr int LDS_BYTES = 131072 + 1024 + 4096;

typedef const Params __attribute__((address_space(4)))* KArg;
struct Ctx { int tid, lane, wave, G, c, gw, NGW; LAS unsigned char* lds; };

enum { I_X = 0, I_C, I_POS, I_WADA, I_BADA, I_N1G, I_WIN, I_AR, I_AI, I_LDT, I_BR, I_BI, I_CR, I_CI, I_SD, I_WGLU, I_BGLU, I_WAOUT, I_QNG, I_WUQ, I_KVNG, I_WUK, I_WUV, I_WBOUT, I_WOUT, I_N2G, I_WGATE, I_WUP, I_WDOWN, I_FING };

__device__ __forceinline__ void sincos_acc(double x, float& s, float& c) {
    const double rev = x * 0.15915494309189535; const double r = rev - __builtin_rint(rev);
    const float th = (float)(r * 6.283185307179586);
    s = sinf(th); c = cosf(th);
}
__device__ __forceinline__ float inv_freq_tab(int i) {
    switch (i) { case 0: return 1.0f; case 1: return 0.5623413324356079f; case 2: return 0.3162277638912201f; case 3: return 0.17782793939113617f; case 4: return 0.10000000149011612f;
    case 5: return 0.05623413249850273f; case 6: return 0.03162277489900589f; case 7: return 0.017782794311642647f; case 8: return 0.009999999776482582f; case 9: return 0.005623413249850273f;
    case 10: return 0.003162277629598975f; case 11: return 0.0017782794311642647f; case 12: return 0.0010000000474974513f; case 13: return 0.000562341301701963f; case 14: return 0.0003162277571391314f;
    default: return 0.00017782794020604342f; }
}
__device__ __forceinline__ void p0_mod(const Ctx& X, KArg P) {
    LAS float* sc = (LAS float*)X.lds;
    LAS float* red = sc + 2048;
    const float* cin = P->in[I_C];
    for (int i = X.tid; i < 2048; i += NTHR) { const float v = cin[i]; sc[i] = v * sigmoidf_(v); }
    __syncthreads();
    float* mod = (float*)(P->ws + WS_MOD);
    for (int unit = X.c; unit < DEPTH * 96; unit += X.G) {
        const int l = unit / 96, cb = unit % 96, kp = X.tid >> 6, cj = X.tid & 63, col = cb * 64 + cj;
        const float* w = P->in[I_WADA] + ((size_t)l * 1024 + kp * 128) * 6144 + col;
        float a0 = 0.f, a1 = 0.f;
#pragma unroll 8
        for (int k = 0; k < 128; ++k) { const float wv = w[(size_t)k * 6144]; a0 += sc[kp * 128 + k] * wv; a1 += sc[1024 + kp * 128 + k] * wv; }
        red[(kp * 64 + cj) * 2] = a0; red[(kp * 64 + cj) * 2 + 1] = a1;
        __syncthreads();
        if (X.tid < 128) { const int b = X.tid >> 6, cj2 = X.tid & 63; float s = 0.f;
#pragma unroll
            for (int q = 0; q < 8; ++q) s += red[(q * 64 + cj2) * 2 + b];
            mod[((size_t)l * 2 + b) * 6144 + cb * 64 + cj2] = s + P->in[I_BADA][(size_t)l * 6144 + cb * 64 + cj2]; }
        __syncthreads();
    }
}
__device__ __forceinline__ void p0_tables(const Ctx& X, KArg P) {
    const int* pos = (const int*)P->in[I_POS];
    float* cosT = (float*)(P->ws + WS_ROPE); float* sinT = cosT + (size_t)T * 16;
    for (int idx = X.c * NTHR + X.tid; idx < T * 16; idx += X.G * NTHR) {
        const int tok = idx >> 4, i = idx & 15;
        const float ang = (float)pos[tok] * inv_freq_tab(i);
        float s, c; sincos_acc((double)ang, s, c);
        cosT[idx] = c; sinT[idx] = s;
    }
    int* tmin = (int*)(P->ws + WS_TPOS); int* tmax = tmin + 512;
    for (int t = X.gw; t < 512; t += X.NGW) {
        int v = pos[t * 64 + X.lane], mn = v, mx = v;
#pragma unroll
        for (int o = 1; o < 64; o <<= 1) { mn = min(mn, shflxi(mn, o, X.lane)); mx = max(mx, shflxi(mx, o, X.lane)); }
        if (X.lane == 0) { tmin[t] = mn; tmax[t] = mx; }
    }
}
__device__ __forceinline__ void ssm_stage1(const Ctx& X, KArg P, int l) {
    const float* a_re = P->in[I_AR] + (size_t)l * NG * SP; const float* a_im = P->in[I_AI] + (size_t)l * NG * SP; const float* ldt = P->in[I_LDT] + (size_t)l * NG;
    f32x2* apow = (f32x2*)(P->ws + WS_APOW); f32x2* bbar = (f32x2*)(P->ws + WS_BBAR);
    for (int idx = X.c * NTHR + X.tid; idx < NG * 66 * 64; idx += X.G * NTHR) {
        const int g = idx / (66 * 64), j = (idx >> 6) % 66, p = idx & 63;
        const float n = (j == 65) ? 2048.0f : (float)j;
        const float dt = expf(ldt[g]), ar = a_re[g * 64 + p], ai = a_im[g * 64 + p];
        const float mag = expf(ar * dt * n); float s, c; sincos_acc((double)ai * (double)dt * (double)n, s, c);
        apow[idx] = (f32x2){mag * c, mag * s};
    }
    const float* b_re = P->in[I_BR] + (size_t)l * NG * SP * 16; const float* b_im = P->in[I_BI] + (size_t)l * NG * SP * 16;
    for (int idx = X.c * NTHR + X.tid; idx < NG * 64 * 16; idx += X.G * NTHR) {
        const int g = idx >> 10, p = (idx >> 4) & 63;
        const float dt = expf(ldt[g]), ar = a_re[g * 64 + p], ai = a_im[g * 64 + p];
        const float mag = expf(ar * dt); float s, c; sincos_acc((double)ai * (double)dt, s, c);
        const float nr = mag * c - 1.0f, ni = mag * s, den = ar * ar + ai * ai;
        const float cr = (nr * ar + ni * ai) / den, ci = (ni * ar - nr * ai) / den;
        const float br = b_re[idx], bi = b_im[idx];
        bbar[idx] = (f32x2){cr * br - ci * bi, cr * bi + ci * br};
    }
}
__device__ __forceinline__ void ssm_stage2(const Ctx& X, KArg P, int l) {
    const f32x2* apow = (const f32x2*)(P->ws + WS_APOW); const f32x2* bbar = (const f32x2*)(P->ws + WS_BBAR);
    const float* c_re = P->in[I_CR] + (size_t)l * NG * 16 * SP; const float* c_im = P->in[I_CI] + (size_t)l * NG * 16 * SP;
    bf16_t* Kg = (bf16_t*)(P->ws + WS_KG); bf16_t* Et = (bf16_t*)(P->ws + WS_ET); bf16_t* Ft = (bf16_t*)(P->ws + WS_FT);
    for (int idx = X.c * NTHR + X.tid; idx < NG * 128 * 64; idx += X.G * NTHR) {
        const int g = idx >> 13, jj = (idx >> 6) & 127, m = (idx >> 2) & 15, mq = idx & 3;
        f32x4 acc = (f32x4){0.f, 0.f, 0.f, 0.f};
        if (jj >= 64) { const int j = jj - 64;
            const float* cr = c_re + (g * 16 + m) * 64; const float* ci = c_im + (g * 16 + m) * 64; const f32x2* ap = apow + (g * 66 + j) * 64; const f32x4* bb = (const f32x4*)(bbar + (size_t)g * 1024 + 4 * mq);
#pragma unroll 4
            for (int p = 0; p < 64; ++p) { const f32x2 a = ap[p]; const f32x4 b01 = bb[p * 8], b23 = bb[p * 8 + 1]; const float wr = cr[p] * a.x - ci[p] * a.y, wi = cr[p] * a.y + ci[p] * a.x;
                acc[0] += wr * b01[0] - wi * b01[1]; acc[1] += wr * b01[2] - wi * b01[3]; acc[2] += wr * b23[0] - wi * b23[1]; acc[3] += wr * b23[2] - wi * b23[3]; } }
        u32x2 w; w.x = cvt_pk_bf16(acc[0], acc[1]); w.y = cvt_pk_bf16(acc[2], acc[3]);
        *(u32x2*)(Kg + (size_t)idx * 4) = w;
    }
    for (int idx = X.c * NTHR + X.tid; idx < NG * 1024 * 128; idx += X.G * NTHR) {
        const int g = idx >> 17, n = (idx >> 7) & 1023, k = idx & 127, t = n >> 4, m = n & 15, p = k & 63;
        const f32x2 a = apow[(g * 66 + t + 1) * 64 + p]; const float cr = c_re[(g * 16 + m) * 64 + p], ci = c_im[(g * 16 + m) * 64 + p];
        const float wr = cr * a.x - ci * a.y, wi = cr * a.y + ci * a.x;
        Et[idx] = f2bf(k < 64 ? wr : -wi);
    }
    for (int idx = X.c * NTHR + X.tid; idx < NG * 128 * 1024; idx += X.G * NTHR) {
        const int g = idx >> 17, n = (idx >> 10) & 127, k = idx & 1023, s = k >> 4, mp = k & 15, p = n & 63;
        const f32x2 a = apow[(g * 66 + 63 - s) * 64 + p], b2 = bbar[(size_t)g * 1024 + p * 16 + mp];
        Ft[idx] = f2bf(n < 64 ? (a.x * b2.x - a.y * b2.y) : (a.x * b2.y + a.y * b2.x));
    }
}
struct SrcCol { const float* p; int ld; };
__device__ __forceinline__ SrcCol src_col(KArg P, int l, int mat, int n) {
    SrcCol r; r.p = nullptr; r.ld = 0;
    switch (mat) {
    case 0: { int s = -1; if (n < 896) s = n; else if (n < 928) { const int i = n - 896; s = 896 + (i >> 1) + (i & 1) * 16; } else if (n < 1024) s = -1; else if (n < 2048) s = 928 + (n - 1024); else s = 1952 + (n - 2048);
              r.ld = INC; if (s >= 0) r.p = P->in[I_WIN] + (size_t)l * 1024 * INC + s; } break;
    case 1: r.ld = 512; r.p = P->in[I_WGLU] + (size_t)l * 512 * 512 + n; break;
    case 2: r.ld = 1024; r.p = P->in[I_WAOUT] + (size_t)l * 512 * 1024 + n; break;
    case 3: r.ld = 1024; r.p = P->in[I_WBOUT] + (size_t)l * 512 * 1024 + n; break;
    case 4: { const int h = n / 96, d = n - h * 96; int s = n; if (d >= 64) { const int i = d - 64; s = h * 96 + 64 + (i >> 1) + (i & 1) * 16; }
              r.ld = 768; r.p = P->in[I_WUQ] + (size_t)l * 256 * 768 + s; } break;
    case 5: r.ld = 512; r.p = P->in[I_WUK] + (size_t)l * 128 * 512 + n; break;
    case 6: r.ld = 512; r.p = P->in[I_WUV] + (size_t)l * 128 * 512 + n; break;
    case 7: r.ld = 1024; r.p = P->in[I_WOUT] + (size_t)l * 1024 * 1024 + n; break;
    case 8: { const int g8 = n >> 3, q = n & 7; r.ld = DFF; r.p = (q < 4 ? P->in[I_WGATE] + (size_t)l * 1024 * DFF + 4 * g8 + q : P->in[I_WUP] + (size_t)l * 1024 * DFF + 4 * g8 + (q - 4)); } break;
    default: r.ld = 1024; r.p = P->in[I_WDOWN] + (size_t)l * DFF * 1024 + n; break;
    }
    return r;
}
template <int MAT, int K, int N>
__device__ __forceinline__ void weights_mat(const Ctx& X, KArg P, int l, bf16_t* Wdst, LAS float* scr, int base) {
    constexpr int nblk = N / 32, items = (K / 64) * nblk;
    const int first = ((X.gw - base) % X.NGW + X.NGW) % X.NGW;
    for (int it = first; it < items; it += X.NGW) {
        const int kb = it / nblk, nb = it % nblk, k0 = 64 * kb, n0 = 32 * nb;
        const SrcCol sc = src_col(P, l, MAT, n0 + (X.lane & 31));
#pragma unroll 8
        for (int i = 0; i < 32; ++i) { const int kk = 2 * i + (X.lane >> 5); scr[kk * 33 + (X.lane & 31)] = sc.p ? sc.p[(size_t)(k0 + kk) * sc.ld] : 0.f; }
        asm volatile("s_waitcnt lgkmcnt(0)" ::: "memory");
        const int ck = X.lane & 7;
#pragma unroll
        for (int j = 0; j < 4; ++j) { const int n = (X.lane >> 3) + 8 * j; const LAS float* s = scr + (8 * ck) * 33 + n;
            u32x4 o; o.x = cvt_pk_bf16(s[0], s[33]); o.y = cvt_pk_bf16(s[2 * 33], s[3 * 33]); o.z = cvt_pk_bf16(s[4 * 33], s[5 * 33]); o.w = cvt_pk_bf16(s[6 * 33], s[7 * 33]);
            *(u32x4*)(Wdst + (size_t)(n0 + n) * K + k0 + 8 * ck) = o; }
        asm volatile("s_waitcnt lgkmcnt(0)" ::: "memory");
    }
}
__device__ __forceinline__ void weights_phase(const Ctx& X, KArg P, int l) {
    bf16_t* W = (bf16_t*)(P->ws + WS_W);
    LAS float* scr = (LAS float*)(X.lds + X.wave * 8448);
    constexpr int I0 = 16 * 96, I1 = 8 * 16, I2 = 8 * 32, I3 = 8 * 32, I4 = 4 * 24, I5 = 2 * 16, I6 = 2 * 16, I7 = 16 * 32, I8 = 16 * 176;
    weights_mat<0, 1024, 3072>(X, P, l, W + WO_IN, scr, 0);
    weights_mat<1, 512, 512>(X, P, l, W + WO_GLU, scr, I0);
    weights_mat<2, 512, 1024>(X, P, l, W + WO_A, scr, I0 + I1);
    weights_mat<3, 512, 1024>(X, P, l, W + WO_B, scr, I0 + I1 + I2);
    weights_mat<4, 256, 768>(X, P, l, W + WO_UQ, scr, I0 + I1 + I2 + I3);
    weights_mat<5, 128, 512>(X, P, l, W + WO_UK, scr, I0 + I1 + I2 + I3 + I4);
    weights_mat<6, 128, 512>(X, P, l, W + WO_UV, scr, I0 + I1 + I2 + I3 + I4 + I5);
    weights_mat<7, 1024, 1024>(X, P, l, W + WO_OUT, scr, I0 + I1 + I2 + I3 + I4 + I5 + I6);
    weights_mat<8, 1024, 5632>(X, P, l, W + WO_GU, scr, I0 + I1 + I2 + I3 + I4 + I5 + I6 + I7);
    weights_mat<9, DFF, 1024>(X, P, l, W + WO_DOWN, scr, I0 + I1 + I2 + I3 + I4 + I5 + I6 + I7 + I8);
}
__device__ __forceinline__ void norm_phase(const Ctx& X, const float* x, const float* gain, const float* mod_sh, const float* mod_sc, bf16_t* h) {
    for (int row0 = X.gw; row0 < T; row0 += 2 * X.NGW) {
        const int row1 = row0 + X.NGW;
        const bool has1 = row1 < T;
        const f32x4* xr0 = (const f32x4*)(x + (size_t)row0 * 1024) + X.lane;
        const f32x4* xr1 = (const f32x4*)(x + (size_t)(has1 ? row1 : row0) * 1024) + X.lane;
        f32x4 v0[4], v1[4]; float ss0 = 0.f, ss1 = 0.f;
#pragma unroll
        for (int j = 0; j < 4; ++j) { v0[j] = xr0[64 * j]; v1[j] = xr1[64 * j]; }
#pragma unroll
        for (int j = 0; j < 4; ++j) { ss0 += (v0[j][0] * v0[j][0] + v0[j][1] * v0[j][1]) + (v0[j][2] * v0[j][2] + v0[j][3] * v0[j][3]);
                                      ss1 += (v1[j][0] * v1[j][0] + v1[j][1] * v1[j][1]) + (v1[j][2] * v1[j][2] + v1[j][3] * v1[j][3]); }
#pragma unroll
        for (int o = 1; o < 64; o <<= 1) { ss0 += shflx(ss0, o, X.lane); ss1 += shflx(ss1, o, X.lane); }
        const float r0 = rsqrtf(ss0 * (1.0f / 1024.0f) + EPS), r1 = rsqrtf(ss1 * (1.0f / 1024.0f) + EPS);
        const int bo0 = row0 >= SEQ ? 6144 : 0, bo1 = row1 >= SEQ ? 6144 : 0;
#pragma unroll
        for (int j = 0; j < 4; ++j) { const int col = 256 * j + 4 * X.lane;
            const f32x4 g4 = *(const f32x4*)(gain + col);
            { const f32x4 s4 = *(const f32x4*)(mod_sc + bo0 + col), h4 = *(const f32x4*)(mod_sh + bo0 + col);
              const f32x4 o = v0[j] * r0 * g4 * (s4 + 1.0f) + h4; u32x2 w; w.x = cvt_pk_bf16(o[0], o[1]); w.y = cvt_pk_bf16(o[2], o[3]);
              *(u32x2*)(h + (size_t)row0 * 1024 + col) = w; }
            if (has1) { const f32x4 s4 = *(const f32x4*)(mod_sc + bo1 + col), h4 = *(const f32x4*)(mod_sh + bo1 + col);
              const f32x4 o = v1[j] * r1 * g4 * (s4 + 1.0f) + h4; u32x2 w; w.x = cvt_pk_bf16(o[0], o[1]); w.y = cvt_pk_bf16(o[2], o[3]);
              *(u32x2*)(h + (size_t)row1 * 1024 + col) = w; } }
    }
}
__device__ __forceinline__ void final_norm_phase(const Ctx& X, float* x, const float* gain) {
    for (int row = X.gw; row < T; row += X.NGW) {
        f32x4* xr = (f32x4*)(x + (size_t)row * 1024) + X.lane;
        f32x4 v[4]; float ss = 0.f;
#pragma unroll
        for (int j = 0; j < 4; ++j) { v[j] = xr[64 * j]; ss += (v[j][0] * v[j][0] + v[j][1] * v[j][1]) + (v[j][2] * v[j][2] + v[j][3] * v[j][3]); }
        const float r = rsqrtf(wave_sum(ss, X.lane) * (1.0f / 1024.0f) + EPS);
#pragma unroll
        for (int j = 0; j < 4; ++j) { const f32x4 g4 = *(const f32x4*)(gain + 256 * j + 4 * X.lane); xr[64 * j] = v[j] * r * g4; }
    }
}
__device__ __forceinline__ void prep_phase(const Ctx& X, KArg P, int l) {
    bf16_t* zx = (bf16_t*)(P->ws + WS_ZX); bf16_t* Kpe = (bf16_t*)(P->ws + WS_KPE);
    const float* cosT = (const float*)(P->ws + WS_ROPE); const float* sinT = cosT + (size_t)T * 16;
    const float* qg = P->in[I_QNG] + (size_t)l * QL; const float* kg = P->in[I_KVNG] + (size_t)l * KVL;
    for (int row = X.gw; row < T; row += X.NGW) {
        bf16_t* zr = zx + (size_t)row * 512;
        const u32x2 cq = *(const u32x2*)(zr + 4 * X.lane); const unsigned ck = *(const unsigned*)(zr + 256 + 2 * X.lane);
        const float q0 = bflo(cq.x), q1 = bfhi(cq.x), q2 = bflo(cq.y), q3 = bfhi(cq.y), k0 = bflo(ck), k1 = bfhi(ck);
        const float rq = rsqrtf(wave_sum((q0 * q0 + q1 * q1) + (q2 * q2 + q3 * q3), X.lane) * (1.0f / 256.0f) + EPS);
        const float rk = rsqrtf(wave_sum(k0 * k0 + k1 * k1, X.lane) * (1.0f / 128.0f) + EPS);
        const f32x4 g4 = *(const f32x4*)(qg + 4 * X.lane); const f32x2 g2 = *(const f32x2*)(kg + 2 * X.lane);
        u32x2 wq; wq.x = cvt_pk_bf16(q0 * rq * g4[0], q1 * rq * g4[1]); wq.y = cvt_pk_bf16(q2 * rq * g4[2], q3 * rq * g4[3]);
        const unsigned wk = cvt_pk_bf16(k0 * rk * g2[0], k1 * rk * g2[1]);
        if (X.lane < 16) { const unsigned kr = *(const unsigned*)(zr + 384 + 2 * X.lane); const float x1 = bflo(kr), x2 = bfhi(kr);
            const float c = cosT[(size_t)row * 16 + X.lane], s = sinT[(size_t)row * 16 + X.lane];
            *(unsigned*)(Kpe + (size_t)row * 32 + 2 * X.lane) = cvt_pk_bf16(x1 * c - x2 * s, x2 * c + x1 * s); }
        *(u32x2*)(zr + 4 * X.lane) = wq; *(unsigned*)(zr + 256 + 2 * X.lane) = wk;
    }
}
__device__ __forceinline__ void carry_phase(const Ctx& X, KArg P) {
    const float* S = (const float*)(P->ws + WS_S); bf16_t* Hc = (bf16_t*)(P->ws + WS_HC); const f32x2* apow = (const f32x2*)(P->ws + WS_APOW);
    LAS f32x2* Ew = (LAS f32x2*)X.lds;
    const int cshift = X.G >= 64 ? X.G - 64 : 0;
    for (int i = X.c - cshift; i < 64; i += X.G) {
        if (i < 0) break;
        const int b = i >> 5, g = i & 31, p = X.lane, w = X.wave;
        const f32x2 a64 = apow[(g * 66 + 64) * 64 + p], a2k = apow[(g * 66 + 65) * 64 + p];
        const size_t r0 = ((size_t)g * NCH + b * 256 + w * 32) * 128;
        float sre[32], sim[32];
#pragma unroll
        for (int cc = 0; cc < 32; ++cc) { sre[cc] = S[r0 + cc * 128 + p]; sim[cc] = S[r0 + cc * 128 + 64 + p]; }
        float hr = 0.f, hi = 0.f;
#pragma unroll
        for (int cc = 0; cc < 32; ++cc) { const float nr = a64.x * hr - a64.y * hi + sre[cc], ni = a64.x * hi + a64.y * hr + sim[cc]; hr = nr; hi = ni; }
        Ew[w * 64 + p] = (f32x2){hr, hi};
        __syncthreads();
        hr = 0.f; hi = 0.f;
        for (int q = 0; q < w; ++q) { const f32x2 e = Ew[q * 64 + p]; const float nr = a2k.x * hr - a2k.y * hi + e.x, ni = a2k.x * hi + a2k.y * hr + e.y; hr = nr; hi = ni; }
#pragma unroll
        for (int cc = 0; cc < 32; ++cc) {
            Hc[r0 + cc * 128 + p] = f2bf(hr); Hc[r0 + cc * 128 + 64 + p] = f2bf(hi);
            const float nr = a64.x * hr - a64.y * hi + sre[cc], ni = a64.x * hi + a64.y * hr + sim[cc]; hr = nr; hi = ni; }
        __syncthreads();
    }
}

#ifndef PHMASK
#define PHMASK 0xffffffffu
#endif
__global__ void __launch_bounds__(NTHR, 2) trunk_fwd(Params Pval) {
    extern __shared__ __attribute__((aligned(16))) unsigned char lds_raw[];
    cg::grid_group grid = cg::this_grid();
    Ctx X; X.lds = (LAS unsigned char*)lds_raw; X.tid = threadIdx.x; X.lane = X.tid & 63; X.wave = __builtin_amdgcn_readfirstlane(X.tid >> 6);
    X.G = gridDim.x; X.c = blockIdx.x; X.gw = X.c * NWAVES + X.wave; X.NGW = X.G * NWAVES;
    using pg8::Gemm; using pg8::Order;
    KArg P = (KArg)__builtin_amdgcn_kernarg_segment_ptr();
    unsigned char* ws;
    unsigned bar_epoch = 0;
#ifdef PROBE_PHASE
    unsigned long long probe_acc = 0, probe_t = 0; int probe_seg = -1;
#define PROBE_TICK() do { const unsigned long long now_ = __builtin_amdgcn_s_memrealtime(); if (probe_seg >= 0 && probe_seg < 16 && ((PROBE_PHASE >> probe_seg) & 1)) probe_acc += now_ - probe_t; probe_t = now_; ++probe_seg; } while (0)
#else
#define PROBE_TICK() do {} while (0)
#endif
    const unsigned my_xcc = (unsigned)__builtin_amdgcn_s_getreg((3 << 11) | 20) & 0xFu;
    volatile LAS unsigned* const bar_lds = (volatile LAS unsigned*)(X.lds + 131072);
#define BAR_LD(p) __hip_atomic_load((p), __ATOMIC_RELAXED, __HIP_MEMORY_SCOPE_AGENT)
#define BAR_ADD(p, v) __hip_atomic_fetch_add((p), (v), __ATOMIC_RELAXED, __HIP_MEMORY_SCOPE_AGENT)
    {
        unsigned* const bw = (unsigned*)(P->ws + WS_BAR);
        if (X.tid == 0) { BAR_ADD(bw + 64 * my_xcc, 1u); BAR_ADD(bw + 3200, 1u); while (BAR_LD(bw + 3200) < (unsigned)X.G) __builtin_amdgcn_s_sleep(1);
            unsigned nl = 1, nxc = 0;
            for (unsigned j = 0; j < 16; ++j) { const unsigned cj = BAR_LD(bw + 64 * j); if (cj) ++nxc; if (j == my_xcc) nl = cj; }
            bar_lds[0] = nl; bar_lds[1] = nxc ? nxc : 1u; }
        __syncthreads();
    }
#define GRID_SYNC() do { asm volatile("s_waitcnt vmcnt(0)" ::: "memory"); __syncthreads(); \
        asm volatile("" : "+s"(P)); unsigned* const bw_ = (unsigned*)(P->ws + WS_BAR); \
        unsigned lb_ = (unsigned)(size_t)X.lds + 131072u; asm volatile("" : "+s"(lb_)); unsigned xc_ = my_xcc; asm volatile("" : "+s"(xc_)); \
        if (X.tid == 0) { const unsigned nl_ = ((volatile LAS unsigned*)lb_)[0], nx_ = ((volatile LAS unsigned*)lb_)[1], k_ = bar_epoch; \
            const unsigned old_ = BAR_ADD(bw_ + 1024 + 64 * xc_, 1u); \
            if (old_ + 1u == (k_ + 1u) * nl_) { __builtin_amdgcn_fence(__ATOMIC_RELEASE, "agent"); asm volatile("s_waitcnt vmcnt(0)" ::: "memory"); \
                const unsigned og_ = BAR_ADD(bw_ + 3072, 1u); \
                if (og_ + 1u == (k_ + 1u) * nx_) BAR_ADD(bw_ + 3136, 1u); else while (BAR_LD(bw_ + 3136) <= k_) __builtin_amdgcn_s_sleep(1); \
                __builtin_amdgcn_fence(__ATOMIC_ACQUIRE, "agent"); BAR_ADD(bw_ + 2048 + 64 * xc_, 1u); asm volatile("s_waitcnt vmcnt(0)" ::: "memory"); } \
            else { while (BAR_LD(bw_ + 2048 + 64 * xc_) <= k_) __builtin_amdgcn_s_sleep(1); __builtin_amdgcn_fence(__ATOMIC_ACQUIRE, "agent"); asm volatile("s_waitcnt vmcnt(0)" ::: "memory"); } } \
        bar_epoch += 1; __syncthreads(); PROBE_TICK(); } while (0)
#define FRESH() do { asm volatile("" : "+s"(P)); asm volatile("v_mbcnt_lo_u32_b32 %0, -1, 0\n\tv_mbcnt_hi_u32_b32 %0, -1, %0" : "=v"(X.lane)); X.tid = X.wave * 64 + X.lane; ws = P->ws; } while (0)
#define mod ((float*)(ws + WS_MOD))
#define cosT ((const float*)(ws + WS_ROPE))
#define sinT (cosT + (size_t)T * 16)
#define tmin ((const int*)(ws + WS_TPOS))
#define tmax (tmin + 512)
#define Wb ((bf16_t*)(ws + WS_W))
#define Hb ((bf16_t*)(ws + WS_H))
#define Ug ((bf16_t*)(ws + WS_UG))
#define zx ((bf16_t*)(ws + WS_ZX))
#define gates ((bf16_t*)(ws + WS_GATES))
#define Qb ((bf16_t*)(ws + WS_Q))
#define Kn ((bf16_t*)(ws + WS_KN))
#define Kpe ((bf16_t*)(ws + WS_KPE))
#define Vt ((bf16_t*)(ws + WS_VT))
#define Ob ((bf16_t*)(ws + WS_O))
#define ypart ((bf16_t*)(ws + WS_YPART))
#define ya ((bf16_t*)(ws + WS_YA))
#define yg ((bf16_t*)(ws + WS_YG))
#define hid ((bf16_t*)(ws + WS_HID))
#define Sb ((float*)(ws + WS_S))
#define Hc ((bf16_t*)(ws + WS_HC))
#define modl (mod + (size_t)l * 2 * 6144)
#define xin ((l == 0) ? P->in[I_X] : (const float*)P->out)

#define PH(n) if (PHMASK & (1u << (n)))
    grid.sync();
    PH(0) { FRESH(); p0_mod(X, P); p0_tables(X, P); weights_phase(X, P, 0); ssm_stage1(X, P, 0); }
    GRID_SYNC();

    for (int l = 0; l < DEPTH; ++l) {
#ifdef PROBE_PHASE
        probe_seg = 0;
#endif
        if (l > 0) PH(1) { FRESH(); weights_phase(X, P, l); ssm_stage1(X, P, l); }
        PH(2) { FRESH(); norm_phase(X, xin, P->in[I_N1G] + (size_t)l * 1024, modl + 0, modl + 1024, Hb); }
        GRID_SYNC();
        PH(3) { FRESH(); ssm_stage2(X, P, l); }
        PH(4) { FRESH(); Gemm g{Hb, Wb + WO_IN, 1024, 1024, 0, 0, 1024}; Order S; S.init(T, 3072, 1, X.G, X.c); pg8::EpiIn E{Ug, zx, gates, Kpe, P->in[I_QNG] + (size_t)l * QL, P->in[I_KVNG] + (size_t)l * KVL, cosT, sinT, X.lds};
          pg8::gemm_phase<pg8::EpiIn, false>(X.lds, g, S, E, X.tid); }
        GRID_SYNC();
        PH(6) { FRESH(); Gemm g{Ug, (const bf16_t*)(ws + WS_FT), 1024, 1024, (size_t)NCH * 1024, (size_t)128 * 1024, 1024}; Order S; S.init(NCH, 256, NG, X.G, X.c); pg8::EpiS E{Sb};
          pg8::gemm_phase<pg8::EpiS, false>(X.lds, g, S, E, X.tid); }
        GRID_SYNC();
        PH(7) { FRESH(); carry_phase(X, P); }
        PH(8) { FRESH(); Gemm g{zx, Wb + WO_UQ, 512, 256, 0, 0, 256}; Order S; S.init(T, 768, 1, X.G, X.c); pg8::EpiQ E{Qb, cosT, sinT, 0.10206207261596577f * 1.4426950408889634f};
          pg8::gemm_phase<pg8::EpiQ, false>(X.lds, g, S, E, X.tid); }
        PH(9) { FRESH(); Gemm g{zx + 256, Wb + WO_UK, 512, 128, 0, 0, 128}; Order S; S.init(T, 512, 1, X.G, X.c); pg8::EpiStore E{Kn, 0, 512};
          pg8::gemm_phase<pg8::EpiStore, false>(X.lds, g, S, E, X.tid); }
        PH(10) { FRESH(); Gemm g{Wb + WO_UV, zx + 256, 128, 512, 0, 0, 128}; Order S; S.init(512, T, 1, X.G, X.c); pg8::EpiStore E{Vt, 0, T};
          pg8::gemm_phase<pg8::EpiStore, false>(X.lds, g, S, E, X.tid); }
        GRID_SYNC();
#ifdef ATT_DUMMY
        PH(11) { FRESH(); for (int idx = X.c * NTHR + X.tid; idx < T * 512; idx += X.G * NTHR) { const int row = idx >> 9, cc = idx & 511, h = cc >> 6, d = cc & 63;
            const float v = bf2f(Qb[(size_t)row * 768 + h * 96 + d]) + bf2f(Qb[(size_t)row * 768 + h * 96 + 64 + (d & 31)]) + bf2f(Kn[(size_t)row * 512 + cc]) + bf2f(Vt[(size_t)cc * T + row]) + bf2f(Kpe[(size_t)row * 32 + (d & 31)]);
            Ob[idx] = f2bf(v * 0.25f); } }
#else
        PH(11) { FRESH(); att::phase(X.lds, Qb, Kn, Kpe, Vt, Ob, (const int*)P->in[I_POS], tmin, tmax, X.G, X.c, X.tid); }
#endif
#ifdef SYNC_AFTER_ATT
        GRID_SYNC();
#endif
        PH(12) { FRESH(); Gemm g{Ug, (const bf16_t*)(ws + WS_KG) + 16384, 1024, 16, (size_t)NCH * 1024, 32768, 1024}; Order S; S.init(NCH, 1024, NG, X.G, X.c); pg8::EpiStore E{ypart, (size_t)NCH * 1024, 1024};
          pg8::gemm_phase<pg8::EpiStore, true>(X.lds, g, S, E, X.tid); }
        PH(13) { FRESH(); Gemm g{Hc, (const bf16_t*)(ws + WS_ET), 128, 128, (size_t)NCH * 128, (size_t)1024 * 128, 128}; Order S; S.init(NCH, 1024, NG, X.G, X.c);
          pg8::EpiE E{ypart, Ug, P->in[I_SD] + (size_t)l * SW, ya};
          pg8::gemm_phase<pg8::EpiE, false>(X.lds, g, S, E, X.tid); }
        GRID_SYNC();
        PH(14) { FRESH(); Gemm g{ya, Wb + WO_GLU, 512, 512, 0, 0, 512}; Order S; S.init(T, 512, 1, X.G, X.c); pg8::EpiGlu E{ya, P->in[I_BGLU] + (size_t)l * SW, yg};
          pg8::gemm_phase<pg8::EpiGlu, false>(X.lds, g, S, E, X.tid); }
        GRID_SYNC();
        if ((512 % X.G) == 0) {
        PH(15) { FRESH(); Gemm g{yg, Wb + WO_A, 512, 512, (size_t)(WS_O - WS_YG) / 2, (size_t)(WO_B - WO_A), 512}; Order S; S.init(T, 1024, 2, X.G, X.c); pg8::EpiMerge2 E{gates, Hb};
          pg8::gemm_phase<pg8::EpiMerge2, false>(X.lds, g, S, E, X.tid); }
        } else {
        PH(15) { FRESH(); Gemm g{yg, Wb + WO_A, 512, 512, 0, 0, 512}; Order S; S.init(T, 1024, 1, X.G, X.c); pg8::EpiMerge<false> E{gates, 0, Hb};
          pg8::gemm_phase<pg8::EpiMerge<false>, false>(X.lds, g, S, E, X.tid); }
        GRID_SYNC();
        PH(16) { FRESH(); Gemm g{Ob, Wb + WO_B, 512, 512, 0, 0, 512}; Order S; S.init(T, 1024, 1, X.G, X.c); pg8::EpiMerge<true> E{gates, 1024, Hb};
          pg8::gemm_phase<pg8::EpiMerge<true>, false>(X.lds, g, S, E, X.tid); }
        }
        GRID_SYNC();
        PH(17) { FRESH(); Gemm g{Hb, Wb + WO_OUT, 1024, 1024, 0, 0, 1024}; Order S; S.init(T, 1024, 1, X.G, X.c); pg8::EpiRes E{xin, P->out, modl + 2048};
          pg8::gemm_phase<pg8::EpiRes, false>(X.lds, g, S, E, X.tid); }
        GRID_SYNC();
        PH(18) { FRESH(); norm_phase(X, P->out, P->in[I_N2G] + (size_t)l * 1024, modl + 3072, modl + 4096, Hb); }
        GRID_SYNC();
        PH(19) { FRESH(); Gemm g{Hb, Wb + WO_GU, 1024, 1024, 0, 0, 1024}; Order S; S.init(T, 5632, 1, X.G, X.c); pg8::EpiGU E{hid};
          pg8::gemm_phase<pg8::EpiGU, false>(X.lds, g, S, E, X.tid); }
        GRID_SYNC();
        PH(20) { FRESH(); Gemm g{hid, Wb + WO_DOWN, DFF, DFF, 0, 0, DFF}; Order S; S.init(T, 1024, 1, X.G, X.c); pg8::EpiRes E{P->out, P->out, modl + 5120};
          pg8::gemm_phase<pg8::EpiRes, false>(X.lds, g, S, E, X.tid); }
        GRID_SYNC();
    }
    PH(21) { FRESH(); final_norm_phase(X, P->out, P->in[I_FING]); }
#ifdef PROBE_PHASE
    GRID_SYNC(); if (blockIdx.x == 0 && X.tid == 0) P->out[0] = PROBE_Q * (float)(int)((float)probe_acc * 0.01f / PROBE_Q + 0.5f);
#endif
}

extern "C" void kernel_launch(void* const* d_in, const int* in_sizes, int n_in, void* d_out, int out_size, void* d_ws, size_t ws_size, hipStream_t stream) {
    static int grid_blocks = 0;
    if (grid_blocks == 0) {
        if (n_in != 30 || ws_size < WS_END) { fprintf(stderr, "kernel_launch: unexpected n_in %d / ws_size %zu (need %zu)\n", n_in, ws_size, (size_t)WS_END); grid_blocks = -1; return; }
        int dev = 0, cus = 0, per_cu = 0;
        hipGetDevice(&dev);
        hipDeviceGetAttribute(&cus, hipDeviceAttributeMultiprocessorCount, dev);
        if (hipFuncSetAttribute((const void*)trunk_fwd, hipFuncAttributeMaxDynamicSharedMemorySize, LDS_BYTES) != hipSuccess) fprintf(stderr, "kernel_launch: hipFuncSetAttribute failed\n");
        hipOccupancyMaxActiveBlocksPerMultiprocessor(&per_cu, (const void*)trunk_fwd, NTHR, LDS_BYTES);
        if (per_cu < 1) per_cu = 1;
        grid_blocks = cus * per_cu;
        fprintf(stderr, "kernel_launch: cus %d per_cu %d grid %d\n", cus, per_cu, grid_blocks);
    }
    if (grid_blocks < 0) return;
    if (hipMemsetAsync((char*)d_ws + WS_BAR, 0, 16384, stream) != hipSuccess) fprintf(stderr, "kernel_launch: memset failed\n");
    Params p{};
    for (int i = 0; i < 30; ++i) p.in[i] = (const float*)d_in[i];
    p.out = (float*)d_out; p.ws = (unsigned char*)d_ws;
    void* args[] = {&p};
    hipError_t e = hipLaunchCooperativeKernel((const void*)trunk_fwd, dim3(grid_blocks), dim3(NTHR), args, LDS_BYTES, stream);
    if (e != hipSuccess) fprintf(stderr, "cooperative launch failed: %s (grid %d)\n", hipGetErrorString(e), grid_blocks);
}
```

```cpp
#include <hip/hip_runtime.h>
#include <hip/hip_cooperative_groups.h>
#include <cstdio>
#include <cstdint>
#include <cstddef>
namespace cg = cooperative_groups;

#define LAS __attribute__((address_space(3)))
typedef unsigned short bf16_t;
typedef short bf16x8 __attribute__((ext_vector_type(8)));
typedef short s16x4 __attribute__((ext_vector_type(4)));
typedef float f32x4 __attribute__((ext_vector_type(4)));
typedef float f32x2 __attribute__((ext_vector_type(2)));
typedef float f32x16 __attribute__((ext_vector_type(16)));
typedef unsigned u32x4 __attribute__((ext_vector_type(4)));
typedef unsigned u32x2 __attribute__((ext_vector_type(2)));
typedef int i32x4 __attribute__((ext_vector_type(4)));

constexpr int D = 1024, BATCH = 2, SEQ = 16384, T = BATCH * SEQ, DEPTH = 4;
constexpr int SW = 512, NG = 32, SP = 64;
constexpr int NH = 8, QKD = 96, QL = 256, KVL = 128;
constexpr int DFF = 2816, INC = 2976;
constexpr int NCH = T / 64;
constexpr float EPS = 1e-6f;

constexpr size_t MiB = 1u << 20;
constexpr size_t WS_MOD = 0, WS_TPOS = 1 * MiB, WS_ROPE = 2 * MiB, WS_APOW = 6 * MiB, WS_BBAR = 8 * MiB, WS_KG = 9 * MiB, WS_ET = 11 * MiB, WS_FT = 19 * MiB,
                 WS_S = 28 * MiB, WS_HC = 36 * MiB, WS_W = 40 * MiB, WS_H = 68 * MiB, WS_UG = 132 * MiB, WS_ZX = 164 * MiB, WS_GATES = 196 * MiB, WS_Q = 324 * MiB,
                 WS_KN = 372 * MiB, WS_KPE = 404 * MiB, WS_VT = 406 * MiB, WS_O = 438 * MiB, WS_YPART = 470 * MiB, WS_END = 502 * MiB;
constexpr size_t WS_BAR = 1 * MiB + 65536;
constexpr size_t WS_YA = WS_ZX, WS_YG = WS_Q, WS_HID = WS_GATES;
constexpr size_t WO_IN = 0, WO_GLU = WO_IN + 3072 * 1024, WO_A = WO_GLU + 512 * 512, WO_B = WO_A + 1024 * 512, WO_UQ = WO_B + 1024 * 512, WO_UK = WO_UQ + 768 * 256,
                 WO_UV = WO_UK + 512 * 128, WO_OUT = WO_UV + 512 * 128, WO_GU = WO_OUT + 1024 * 1024, WO_DOWN = WO_GU + 5632 * 1024, WO_END = WO_DOWN + 1024 * 2816;
static_assert(WO_END * 2 <= 28 * MiB, "weight region");

struct Params {
    const float* in[30];
    float* out;
    unsigned char* ws;
};

typedef __bf16 bf16x2_t __attribute__((ext_vector_type(2)));
__device__ __forceinline__ unsigned cvt_pk_bf16(float lo, float hi) { f32x2 v = {lo, hi}; bf16x2_t b = __builtin_convertvector(v, bf16x2_t); return __builtin_bit_cast(unsigned, b); }
__device__ __forceinline__ bf16_t f2bf(float f) { unsigned u = __builtin_bit_cast(unsigned, f); return (bf16_t)((u + 0x7fffu + ((u >> 16) & 1u)) >> 16); }
__device__ __forceinline__ float bf2f(unsigned short h) { return __builtin_bit_cast(float, (unsigned)h << 16); }
__device__ __forceinline__ float bflo(unsigned w) { return __builtin_bit_cast(float, w << 16); }
__device__ __forceinline__ float bfhi(unsigned w) { return __builtin_bit_cast(float, w & 0xffff0000u); }
__device__ __forceinline__ float sigmoidf_(float x) { return __builtin_amdgcn_rcpf(1.0f + __expf(-x)); }
__device__ __forceinline__ float gelu_tanh(float x) { const float z = 1.5957691216f * (x + 0.044715f * x * x * x); return x * sigmoidf_(z); }
__device__ __forceinline__ u32x4 pack8(const f32x4 a, const f32x4 b) { u32x4 w; w.x = cvt_pk_bf16(a[0], a[1]); w.y = cvt_pk_bf16(a[2], a[3]); w.z = cvt_pk_bf16(b[0], b[1]); w.w = cvt_pk_bf16(b[2], b[3]); return w; }
__device__ __forceinline__ void unpack8(const u32x4 w, f32x4& a, f32x4& b) { a = (f32x4){bflo(w.x), bfhi(w.x), bflo(w.y), bfhi(w.y)}; b = (f32x4){bflo(w.z), bfhi(w.z), bflo(w.w), bfhi(w.w)}; }
__device__ __forceinline__ float shflx(float v, int o, int lane) { return __builtin_bit_cast(float, __builtin_amdgcn_ds_bpermute((lane ^ o) << 2, __builtin_bit_cast(int, v))); }
__device__ __forceinline__ int shflxi(int v, int o, int lane) { return __builtin_amdgcn_ds_bpermute((lane ^ o) << 2, v); }
__device__ __forceinline__ float wave_sum(float v, int lane) {
#pragma unroll
    for (int o = 1; o < 64; o <<= 1) v += shflx(v, o, lane);
    return v;
}

namespace pg8 {
constexpr int BM = 256, BK = 64, HALF = 128, HTB = HALF * BK * 2, STAGE_BYTES = 8 * HTB, NXCD = 8, WGM = 8;
__device__ __forceinline__ int lds_byte(int r, int c) { const int st = (r >> 4) * 2 + (c >> 5), rr = r & 15, cc = c & 31, ob = rr * 64 + cc * 2; return st * 1024 + (ob ^ (((ob >> 9) & 1) << 5)); }
__device__ __forceinline__ void stage_rc(int b, int& R, int& C) { const int st = b / 1024, sb = b % 1024, swz = sb ^ (((sb >> 9) & 1) << 5); R = (st >> 1) * 16 + swz / 64; C = (st & 1) * 32 + (swz % 64) / 2; }
__device__ __forceinline__ int perm32(int rho) { const int n = rho >> 4, i = rho & 15; return 8 * (i >> 2) + 4 * n + (i & 3); }

struct Unit { int g, pm, pn; };
struct Gemm { const bf16_t* A; const bf16_t* Bt; int lda, ldb; size_t gsA, gsB; int K; };

struct Order {
    int nM, nN, per, total, G, c;
    __device__ void init(int M, int N, int groups, int G_, int c_) { nM = M / BM; nN = N / BM; per = nM * nN; total = per * groups; G = G_; c = c_; }
    __device__ bool next(int i, Unit& u) const {
        const int L = i * G + c; if (L >= total) return false;
        const int grp = L / per; int wgid = L - grp * per;
        { const int q = per / NXCD, r = per % NXCD, xcd = wgid % NXCD, off = wgid / NXCD; wgid = (xcd < r ? xcd * (q + 1) : r * (q + 1) + (xcd - r) * q) + off; }
        const int nig = WGM * nN, gid = wgid / nig, fm = gid * WGM, gsz = (nM - fm) < WGM ? (nM - fm) : WGM;
        u.g = grp; u.pm = fm + ((wgid % nig) % gsz); u.pn = (wgid % nig) / gsz; return true;
    }
};

template <class Epi, bool TOEP>
__device__ __forceinline__ void gemm_phase(LAS unsigned char* lds, const Gemm g, const Order& S, const Epi& E, int tid_in) {
    int tid_ = tid_in; asm volatile("" : "+v"(tid_));
    const int tid = tid_, wid = __builtin_amdgcn_readfirstlane(tid >> 6), lane = tid & 63, wr = wid >> 2, wc = wid & 3, fr = lane & 15, fq = lane >> 4;
    const int K = g.K, nt = K / BK;
    unsigned voffA[2], voffB[2];
#pragma unroll
    for (int i = 0; i < 2; ++i) { int R, C; stage_rc(tid * 16 + i * 8192, R, C); const int Rb = (R & ~31) + perm32(R & 31);
        voffA[i] = (unsigned)(R * g.lda + C) * 2u; voffB[i] = TOEP ? (unsigned)(Rb * g.ldb + (C & 15) - (C >> 4) * 256 + 768) * 2u : (unsigned)(Rb * g.ldb + C) * 2u; }
    const ptrdiff_t kstepA = (ptrdiff_t)(BK * 2), kstepB = TOEP ? (ptrdiff_t)-2048 : (ptrdiff_t)(BK * 2);
    const ptrdiff_t hstepA = (ptrdiff_t)HALF * g.lda * 2, hstepB = (ptrdiff_t)HALF * g.ldb * 2;
    const unsigned ldsb = (unsigned)(size_t)lds + (unsigned)wid * 1024u;
    const int aoff = lds_byte(wr * 64 + fr, fq * 8), boff = lds_byte(wc * 32 + fr, fq * 8);
#define PG8_UA(u) ((const char*)g.A + ((size_t)(u).g * g.gsA + (size_t)(u).pm * BM * g.lda) * 2)
#define PG8_UB(u) ((const char*)g.Bt + ((size_t)(u).g * g.gsB + (size_t)(u).pn * BM * g.ldb) * 2 - (TOEP ? 1536 : 0))
#define PG8_SA(b, h) (((b) * 2 + (h)) * HTB)
#define PG8_SB(b, h) ((4 + (b) * 2 + (h)) * HTB)
#define PG8_STAGE(bufoff, gbase, voff) do { _Pragma("unroll") for (int _i = 0; _i < 2; ++_i) { unsigned keep_; \
        asm volatile("s_mov_b32 %0, m0\n\ts_mov_b32 m0, %3\n\ts_nop 0\n\tglobal_load_lds_dwordx4 %1, %2\n\ts_mov_b32 m0, %0" : "=&s"(keep_) : "v"((voff)[_i]), "s"((const char*)(gbase)), "s"(ldsb + (unsigned)((bufoff) + _i * 8192)) : "memory"); } } while (0)
#define PG8_LDA(dst, b, h) do { _Pragma("unroll") for (int m = 0; m < 4; ++m) _Pragma("unroll") for (int k = 0; k < 2; ++k) dst[m][k] = *(const LAS bf16x8*)(lds + PG8_SA(b, h) + aoff + m * 2048 + k * 1024); } while (0)
#define PG8_LDB(dst, b, h) do { _Pragma("unroll") for (int n = 0; n < 2; ++n) _Pragma("unroll") for (int k = 0; k < 2; ++k) dst[n][k] = *(const LAS bf16x8*)(lds + PG8_SB(b, h) + boff + n * 2048 + k * 1024); } while (0)
#define PG8_MMA(ai, bj, At, Bt) do { __builtin_amdgcn_s_setprio(1); _Pragma("unroll") for (int m = 0; m < 4; ++m) _Pragma("unroll") for (int n = 0; n < 2; ++n) _Pragma("unroll") for (int k = 0; k < 2; ++k) \
        acc[ai][bj][m][n] = __builtin_amdgcn_mfma_f32_16x16x32_bf16(Bt[n][k], At[m][k], acc[ai][bj][m][n], 0, 0, 0); __builtin_amdgcn_s_setprio(0); } while (0)
#define PG8_WAIT_V(n) asm volatile("s_waitcnt vmcnt(" #n ")" ::: "memory")
#define PG8_WAIT_L(n) asm volatile("s_waitcnt lgkmcnt(" #n ")" ::: "memory")
#define PG8_BAR __builtin_amdgcn_s_barrier()
#define PG8_SCHED __builtin_amdgcn_sched_barrier(0)
    Unit cur, nxt; int ui = 0;
    if (!S.next(0, cur)) return;
    f32x4 acc[2][2][4][2];
#pragma unroll
    for (int a = 0; a < 2; ++a)
#pragma unroll
        for (int b = 0; b < 2; ++b)
#pragma unroll
            for (int m = 0; m < 4; ++m)
#pragma unroll
                for (int n = 0; n < 2; ++n) acc[a][b][m][n] = (f32x4){0.f, 0.f, 0.f, 0.f};
    bf16x8 At[4][2], B0[2][2], B1[2][2];
    const char* cA = PG8_UA(cur); const char* cB = PG8_UB(cur);
    PG8_STAGE(PG8_SB(0, 0), cB, voffB); PG8_STAGE(PG8_SB(0, 1), cB + hstepB, voffB); PG8_STAGE(PG8_SA(0, 0), cA, voffA); PG8_STAGE(PG8_SA(0, 1), cA + hstepA, voffA);
    if (wr == 1) PG8_BAR;
    PG8_WAIT_V(2); PG8_BAR;
    PG8_STAGE(PG8_SB(1, 0), cB + kstepB, voffB); PG8_STAGE(PG8_SA(1, 0), cA + kstepA, voffA); PG8_STAGE(PG8_SB(1, 1), cB + hstepB + kstepB, voffB);
    PG8_WAIT_V(6); PG8_BAR;
    for (;;) {
        const bool has_next = S.next(ui + 1, nxt);
        const char* nA = has_next ? PG8_UA(nxt) : cA; const char* nB = has_next ? PG8_UB(nxt) : cB;
        for (int t = 0; t < nt; t += 2) {
            const bool last = (t == nt - 2);
            asm volatile("" : "+v"(voffA[0]), "+v"(voffA[1]), "+v"(voffB[0]), "+v"(voffB[1]));
            const char* a1 = cA + (ptrdiff_t)(t + 1) * kstepA;
            const char* a2 = last ? nA : cA + (ptrdiff_t)(t + 2) * kstepA; const char* b2 = last ? nB : cB + (ptrdiff_t)(t + 2) * kstepB;
            const char* a3 = a2 + kstepA; const char* b3 = b2 + kstepB;
            PG8_LDB(B0, 0, 0); PG8_LDB(B1, 0, 1); PG8_SCHED; PG8_LDA(At, 0, 0); PG8_STAGE(PG8_SA(1, 1), a1 + hstepA, voffA);
            PG8_WAIT_V(8); PG8_WAIT_L(0); PG8_BAR; PG8_MMA(0, 0, At, B0); PG8_MMA(0, 1, At, B1); PG8_BAR; PG8_SCHED;
            PG8_LDA(At, 0, 1); PG8_STAGE(PG8_SB(0, 0), b2, voffB); PG8_STAGE(PG8_SB(0, 1), b2 + hstepB, voffB); PG8_STAGE(PG8_SA(0, 0), a2, voffA);
            PG8_WAIT_V(8); PG8_WAIT_L(0); PG8_BAR; PG8_MMA(1, 0, At, B0); PG8_MMA(1, 1, At, B1); PG8_BAR; PG8_SCHED;
            PG8_LDB(B0, 1, 0); PG8_LDB(B1, 1, 1); PG8_SCHED; PG8_LDA(At, 1, 0); PG8_STAGE(PG8_SA(0, 1), a2 + hstepA, voffA);
            PG8_WAIT_V(8); PG8_WAIT_L(0); PG8_BAR; PG8_MMA(0, 0, At, B0); PG8_MMA(0, 1, At, B1); PG8_BAR; PG8_SCHED;
            PG8_LDA(At, 1, 1); PG8_STAGE(PG8_SB(1, 0), b3, voffB); PG8_STAGE(PG8_SB(1, 1), b3 + hstepB, voffB); PG8_STAGE(PG8_SA(1, 0), a3, voffA);
            PG8_WAIT_V(8); PG8_WAIT_L(0); PG8_BAR; PG8_MMA(1, 0, At, B0); PG8_MMA(1, 1, At, B1); PG8_BAR; PG8_SCHED;
        }
        if (wr == 0) PG8_BAR;
        { int frx = fr, fqx = fq; asm volatile("" : "+v"(frx), "+v"(fqx)); E(acc, cur, wr, wc, frx, fqx); }
        if (!has_next) break;
#pragma unroll
        for (int a = 0; a < 2; ++a)
#pragma unroll
            for (int b = 0; b < 2; ++b)
#pragma unroll
                for (int m = 0; m < 4; ++m)
#pragma unroll
                    for (int n = 0; n < 2; ++n) acc[a][b][m][n] = (f32x4){0.f, 0.f, 0.f, 0.f};
        cur = nxt; cA = nA; cB = nB; ++ui;
        if (wr == 1) PG8_BAR;
    }
    PG8_WAIT_V(0);
    PG8_BAR;
#undef PG8_UA
#undef PG8_UB
#undef PG8_SA
#undef PG8_SB
#undef PG8_STAGE
#undef PG8_LDA
#undef PG8_LDB
#undef PG8_MMA
#undef PG8_WAIT_V
#undef PG8_WAIT_L
#undef PG8_BAR
#undef PG8_SCHED
}

#define EPI_BEGIN \
    _Pragma("unroll") for (int ai = 0; ai < 2; ++ai) _Pragma("unroll") for (int m = 0; m < 4; ++m) { \
        const int row = u.pm * 256 + ai * 128 + wr * 64 + m * 16 + fr; \
        _Pragma("unroll") for (int bj = 0; bj < 2; ++bj) { \
            const int col = u.pn * 256 + bj * 128 + wc * 32 + 8 * fq; \
            f32x4 v0 = acc[ai][bj][m][0], v1 = acc[ai][bj][m][1];
#define EPI_END } if (m == 3) asm volatile("" ::: "memory"); }
#define EPI_SIG const f32x4 (&acc)[2][2][4][2], const Unit& u, int wr, int wc, int fr, int fq

struct EpiStore { bf16_t* O; size_t gs; int ldc;
    __device__ __forceinline__ void operator()(EPI_SIG) const {
        EPI_BEGIN *(u32x4*)(O + (size_t)u.g * gs + (size_t)row * ldc + col) = pack8(v0, v1); EPI_END } };
struct EpiIn { bf16_t* Ug; bf16_t* zx; bf16_t* gates; bf16_t* Kpe; const float* qg; const float* kg; const float* cosT; const float* sinT; LAS unsigned char* lds;
    __device__ __forceinline__ void operator()(EPI_SIG) const {
        if (u.pn < 2) { EPI_BEGIN *(u32x4*)(Ug + ((size_t)((col >> 4) * NCH + (row >> 6)) * 1024 + (row & 63) * 16 + (col & 15))) = pack8(v0, v1); EPI_END }
        else if (u.pn < 4) {
            const bool isq = (u.pn == 2); const int lane = fr + 16 * fq;
            LAS float* red = (LAS float*)(lds + 131072 + 1024);
#pragma unroll
            for (int ai = 0; ai < 2; ++ai)
#pragma unroll
                for (int m = 0; m < 4; ++m) { float p = 0.f;
#pragma unroll
                    for (int bj = 0; bj < 2; ++bj) if (isq || bj == 0) { const f32x4 a = acc[ai][bj][m][0], b = acc[ai][bj][m][1];
                        p += (a[0] * a[0] + a[1] * a[1]) + (a[2] * a[2] + a[3] * a[3]) + (b[0] * b[0] + b[1] * b[1]) + (b[2] * b[2] + b[3] * b[3]); }
                    p += shflx(p, 16, lane); p += shflx(p, 32, lane);
                    if (fq == 0) red[(ai * 128 + wr * 64 + m * 16 + fr) * 4 + wc] = p; }
            asm volatile("s_waitcnt lgkmcnt(0)" ::: "memory"); __builtin_amdgcn_s_barrier(); asm volatile("" ::: "memory");
            const float invn = isq ? (1.0f / 256.0f) : (1.0f / 128.0f);
#pragma unroll
            for (int ai = 0; ai < 2; ++ai)
#pragma unroll
                for (int m = 0; m < 4; ++m) { const int rl = ai * 128 + wr * 64 + m * 16 + fr, row = u.pm * 256 + rl;
                    const f32x4 ps = *(const LAS f32x4*)(red + rl * 4); const float r = rsqrtf(((ps[0] + ps[1]) + (ps[2] + ps[3])) * invn + EPS);
#pragma unroll
                    for (int bj = 0; bj < 2; ++bj) { const int cl = bj * 128 + wc * 32 + 8 * fq; f32x4 v0 = acc[ai][bj][m][0], v1 = acc[ai][bj][m][1];
                        if (isq || bj == 0) { const float* gp = isq ? qg + cl : kg + cl; const f32x4 g0 = *(const f32x4*)gp, g1 = *(const f32x4*)(gp + 4);
                            v0 = v0 * r * g0; v1 = v1 * r * g1; *(u32x4*)(zx + (size_t)row * 512 + (isq ? 0 : 256) + cl) = pack8(v0, v1); }
                        else if (wc == 0) { const int i0 = 4 * fq; const f32x4 c4 = *(const f32x4*)(cosT + (size_t)row * 16 + i0), s4 = *(const f32x4*)(sinT + (size_t)row * 16 + i0);
                            f32x4 o0, o1;
                            o0[0] = v0[0] * c4[0] - v0[1] * s4[0]; o0[1] = v0[1] * c4[0] + v0[0] * s4[0]; o0[2] = v0[2] * c4[1] - v0[3] * s4[1]; o0[3] = v0[3] * c4[1] + v0[2] * s4[1];
                            o1[0] = v1[0] * c4[2] - v1[1] * s4[2]; o1[1] = v1[1] * c4[2] + v1[0] * s4[2]; o1[2] = v1[2] * c4[3] - v1[3] * s4[3]; o1[3] = v1[3] * c4[3] + v1[2] * s4[3];
                            *(u32x4*)(Kpe + (size_t)row * 32 + 8 * fq) = pack8(o0, o1); } } }
            asm volatile("s_waitcnt lgkmcnt(0)" ::: "memory"); __builtin_amdgcn_s_barrier(); asm volatile("" ::: "memory");
        }
        else { EPI_BEGIN
#pragma unroll
            for (int i = 0; i < 4; ++i) { v0[i] = sigmoidf_(v0[i]); v1[i] = sigmoidf_(v1[i]); }
            *(u32x4*)(gates + (size_t)row * 2048 + (col - 1024)) = pack8(v0, v1); EPI_END } } };
struct EpiQ { bf16_t* Q; const float* cosT; const float* sinT; float scale;
    __device__ __forceinline__ void operator()(EPI_SIG) const {
        EPI_BEGIN
            const int head = col / 96, d = col - head * 96;
            v0 = v0 * scale; v1 = v1 * scale;
            if (d >= 64) { const int i0 = (d - 64) >> 1; const f32x4 c4 = *(const f32x4*)(cosT + (size_t)row * 16 + i0), s4 = *(const f32x4*)(sinT + (size_t)row * 16 + i0);
                const f32x4 a = v0, b = v1;
                v0[0] = a[0] * c4[0] - a[1] * s4[0]; v0[1] = a[1] * c4[0] + a[0] * s4[0]; v0[2] = a[2] * c4[1] - a[3] * s4[1]; v0[3] = a[3] * c4[1] + a[2] * s4[1];
                v1[0] = b[0] * c4[2] - b[1] * s4[2]; v1[1] = b[1] * c4[2] + b[0] * s4[2]; v1[2] = b[2] * c4[3] - b[3] * s4[3]; v1[3] = b[3] * c4[3] + b[2] * s4[3]; }
            *(u32x4*)(Q + (size_t)row * 768 + col) = pack8(v0, v1);
        EPI_END } };
struct EpiS { float* S;
    __device__ __forceinline__ void operator()(EPI_SIG) const {
        EPI_BEGIN if (bj == 0) { float* p = S + ((size_t)u.g * NCH + row) * 128 + col; *(f32x4*)p = v0; *(f32x4*)(p + 4) = v1; } EPI_END } };
struct EpiE { const bf16_t* ypart; const bf16_t* Ug; const float* dskip; bf16_t* ya;
    __device__ __forceinline__ void operator()(EPI_SIG) const {
        EPI_BEGIN
            const size_t off = ((size_t)u.g * NCH + row) * 1024 + col;
            f32x4 p0, p1, u0, u1; unpack8(*(const u32x4*)(ypart + off), p0, p1); unpack8(*(const u32x4*)(Ug + off), u0, u1);
            const float* dp = dskip + u.g * 16 + (col & 15); const f32x4 d0 = *(const f32x4*)dp, d1 = *(const f32x4*)(dp + 4);
            v0 = v0 + p0 + d0 * u0; v1 = v1 + p1 + d1 * u1;
#pragma unroll
            for (int i = 0; i < 4; ++i) { v0[i] = gelu_tanh(v0[i]); v1[i] = gelu_tanh(v1[i]); }
            *(u32x4*)(ya + ((size_t)row * 64 + (col >> 4)) * 512 + u.g * 16 + (col & 15)) = pack8(v0, v1);
        EPI_END } };
struct EpiGlu { const bf16_t* ya; const float* bias; bf16_t* yg;
    __device__ __forceinline__ void operator()(EPI_SIG) const {
        EPI_BEGIN
            f32x4 y0, y1; unpack8(*(const u32x4*)(ya + (size_t)row * 512 + col), y0, y1);
            const f32x4 b0 = *(const f32x4*)(bias + col), b1 = *(const f32x4*)(bias + col + 4);
#pragma unroll
            for (int i = 0; i < 4; ++i) { v0[i] = y0[i] * sigmoidf_(v0[i] + b0[i]); v1[i] = y1[i] * sigmoidf_(v1[i] + b1[i]); }
            *(u32x4*)(yg + (size_t)row * 512 + col) = pack8(v0, v1);
        EPI_END } };
template <bool ACCUM> struct EpiMerge { const bf16_t* gates; int goff; bf16_t* mg;
    __device__ __forceinline__ void operator()(EPI_SIG) const {
        EPI_BEGIN
            f32x4 g0, g1; unpack8(*(const u32x4*)(gates + (size_t)row * 2048 + goff + col), g0, g1);
            v0 = v0 * g0; v1 = v1 * g1;
            if (ACCUM) { f32x4 o0, o1; unpack8(*(const u32x4*)(mg + (size_t)row * 1024 + col), o0, o1); v0 = v0 + o0; v1 = v1 + o1; }
            *(u32x4*)(mg + (size_t)row * 1024 + col) = pack8(v0, v1);
        EPI_END } };
struct EpiMerge2 { const bf16_t* gates; bf16_t* mg;
    __device__ __forceinline__ void operator()(EPI_SIG) const {
        if (u.g == 0) { EpiMerge<false> e{gates, 0, mg}; e(acc, u, wr, wc, fr, fq); } else { EpiMerge<true> e{gates, 1024, mg}; e(acc, u, wr, wc, fr, fq); } } };
struct EpiRes { const float* xin; float* xout; const float* gmod;
    __device__ __forceinline__ void operator()(EPI_SIG) const {
        EPI_BEGIN
            const float* gp = gmod + (row >= SEQ ? 6144 : 0) + col; const f32x4 g0 = *(const f32x4*)gp, g1 = *(const f32x4*)(gp + 4);
            const float* xp = xin + (size_t)row * 1024 + col; float* op = xout + (size_t)row * 1024 + col;
            const f32x4 x0 = *(const f32x4*)xp, x1 = *(const f32x4*)(xp + 4);
            *(f32x4*)op = x0 + g0 * v0; *(f32x4*)(op + 4) = x1 + g1 * v1;
        EPI_END } };
struct EpiGU { bf16_t* hid;
    __device__ __forceinline__ void operator()(EPI_SIG) const {
        EPI_BEGIN
#pragma unroll
            for (int i = 0; i < 4; ++i) v0[i] = v0[i] * sigmoidf_(v0[i]) * v1[i];
            u32x2 w; w.x = cvt_pk_bf16(v0[0], v0[1]); w.y = cvt_pk_bf16(v0[2], v0[3]);
            *(u32x2*)(hid + (size_t)row * DFF + (col >> 1)) = w;
        EPI_END } };
}

namespace att {
constexpr int KSTR = 208, VSTR = 144, KBUF = 64 * KSTR, VBUF = 64 * VSTR, OFF_V = 3 * KBUF, OFF_P = OFF_V + 3 * VBUF, LDS_BYTES = OFF_P + 768;
constexpr float NEG = -1.0e30f;

__device__ __forceinline__ void phase(LAS unsigned char* lds, const bf16_t* __restrict__ Q, const bf16_t* __restrict__ Kn, const bf16_t* __restrict__ Kpe, const bf16_t* __restrict__ Vt,
                                      bf16_t* __restrict__ O, const int* __restrict__ pos, const int* __restrict__ tmin, const int* __restrict__ tmax, int G, int c, int tid_in) {
    int tid_ = tid_in; asm volatile("" : "+v"(tid_));
    const int tid = tid_, wave = __builtin_amdgcn_readfirstlane(tid >> 6), lane = tid & 63, q32 = lane & 31, hi = lane >> 5;
    for (int ui = c; ui < 1024; ui += G) {
        const int rnd = ui >> 8, c8 = ui & 255, cc = (G == 256) ? ((2 * (c8 & 7) + (c8 >> 7)) * 16 + ((c8 >> 3) & 15)) : c8, bh = cc >> 4, j16 = cc & 15;
        const int qb = rnd == 0 ? 63 - j16 : rnd == 1 ? 32 + j16 : rnd == 2 ? 31 - j16 : j16;
        const int b = bh >> 3, h = bh & 7;
        const int* tmn = tmin + b * 256; const int* tmx = tmax + b * 256;
        int qmax = tmx[qb * 4], qmin = tmn[qb * 4];
#pragma unroll
        for (int i = 1; i < 4; ++i) { qmax = max(qmax, tmx[qb * 4 + i]); qmin = min(qmin, tmn[qb * 4 + i]); }
        const size_t tok0 = (size_t)b * SEQ;
        const size_t qrow = tok0 + qb * 256 + wave * 32 + q32;
        bf16x8 qf[6];
        { const bf16_t* qp = Q + qrow * 768 + h * 96 + 8 * hi;
#pragma unroll
          for (int j = 0; j < 6; ++j) qf[j] = *(const bf16x8*)(qp + 16 * j); }
        const int posq = pos[qrow];
        f32x16 o0, o1;
#pragma unroll
        for (int r = 0; r < 16; ++r) { o0[r] = 0.f; o1[r] = 0.f; }
        float mrun = NEG, lrun = 0.f;
        const int krow = tid >> 3, kpc = tid & 7, prow = (tid & 255) >> 2, ppc = tid & 3;
        const bf16_t* kn_src = Kn + (tok0 + krow) * 512 + h * 64 + kpc * 8;
        const bf16_t* kp_src = Kpe + (tok0 + prow) * 32 + ppc * 8;
        const bf16_t* vt_src = Vt + (size_t)(h * 64 + krow) * T + tok0 + kpc * 8;
        const int* ps_src = pos + tok0 + (tid & 63);
        unsigned long long vm[4], mm[4];
#pragma unroll
        for (int i = 0; i < 4; ++i) { const int a_ = tmn[lane + 64 * i], b_ = tmx[lane + 64 * i]; vm[i] = __builtin_amdgcn_ballot_w64(a_ <= qmax); mm[i] = __builtin_amdgcn_ballot_w64(b_ > qmin); }
        int it_w = 0; unsigned long long it_c = vm[0], it_m = mm[0];
#define ATT_ITER(res_) do { \
            while (it_c == 0ull && it_w < 3) { ++it_w; it_c = it_w == 1 ? vm[1] : it_w == 2 ? vm[2] : vm[3]; it_m = it_w == 1 ? mm[1] : it_w == 2 ? mm[2] : mm[3]; } \
            if (it_c == 0ull) res_ = 256; \
            else { const int b_ = (int)__builtin_ctzll(it_c); res_ = 64 * it_w + b_ + (int)((it_m >> b_) & 1ull) * 512; it_c &= it_c - 1ull; } } while (0)
        u32x4 rkA, rpA, rvA, rkB, rpB, rvB; int rposA = 0, rposB = 0;
        rpA = (u32x4){0u, 0u, 0u, 0u}; rpB = rpA;
#define ATT_LOAD(S, kt_) do { rk##S = *(const u32x4*)(kn_src + (size_t)(kt_) * 64 * 512); if (tid < 256) rp##S = *(const u32x4*)(kp_src + (size_t)(kt_) * 64 * 32); \
        rv##S = *(const u32x4*)(vt_src + (size_t)(kt_) * 64); if (tid < 64) rpos##S = ps_src[(kt_) * 64]; } while (0)
#define ATT_STORE(S, bf_) do { *(LAS u32x4*)(lds + (bf_) * KBUF + krow * KSTR + kpc * 16) = rk##S; if (tid < 256) *(LAS u32x4*)(lds + (bf_) * KBUF + prow * KSTR + 128 + ppc * 16) = rp##S; \
        LAS unsigned char* vp_ = lds + OFF_V + (bf_) * VBUF + krow * VSTR + (kpc >> 1) * 32 + (kpc & 1) * 8; *(LAS u32x2*)vp_ = (u32x2){rv##S.x, rv##S.y}; *(LAS u32x2*)(vp_ + 16) = (u32x2){rv##S.z, rv##S.w}; \
        if (tid < 64) *(LAS int*)(lds + OFF_P + (bf_) * 256 + tid * 4) = rpos##S; } while (0)
#define ATT_QK(bf_) do { \
            const LAS unsigned char* kb = lds + (bf_) * KBUF + q32 * KSTR + hi * 16; \
            bf16x8 kf0[6], kf1[6]; \
            _Pragma("unroll") for (int j = 0; j < 6; ++j) { kf0[j] = *(const LAS bf16x8*)(kb + j * 32); kf1[j] = *(const LAS bf16x8*)(kb + 32 * KSTR + j * 32); } \
            _Pragma("unroll") for (int r = 0; r < 16; ++r) { s0[r] = 0.f; s1[r] = 0.f; } \
            _Pragma("unroll") for (int j = 0; j < 6; ++j) { s0 = __builtin_amdgcn_mfma_f32_32x32x16_bf16(kf0[j], qf[j], s0, 0, 0, 0); s1 = __builtin_amdgcn_mfma_f32_32x32x16_bf16(kf1[j], qf[j], s1, 0, 0, 0); } \
        } while (0)
#define ATT_SM(bf_, kt_) do { \
            const bool need_mask = ((kt_) & 512) != 0; \
            if (need_mask) { \
                const LAS int* pp = (const LAS int*)(lds + OFF_P + (bf_) * 256) + 4 * hi; \
                _Pragma("unroll") for (int i = 0; i < 4; ++i) { \
                    const i32x4 p0 = *(const LAS i32x4*)(pp + 8 * i), p1 = *(const LAS i32x4*)(pp + 32 + 8 * i); \
                    _Pragma("unroll") for (int e = 0; e < 4; ++e) { if (p0[e] > posq) s0[4 * i + e] = NEG; if (p1[e] > posq) s1[4 * i + e] = NEG; } } } \
            float mx = __builtin_amdgcn_fmed3f(s0[0], s1[0], INFINITY); \
            _Pragma("unroll") for (int r = 1; r < 16; ++r) { mx = __builtin_amdgcn_fmed3f(mx, s0[r], INFINITY); mx = __builtin_amdgcn_fmed3f(mx, s1[r], INFINITY); } \
            mx = __builtin_amdgcn_fmed3f(mx, shflx(mx, 32, lane), INFINITY); \
            if (__builtin_amdgcn_ballot_w64(mx > mrun) != 0ull) { \
                const float mnew = fmaxf(mrun, mx); const float alpha = __builtin_amdgcn_exp2f(mrun - mnew); mrun = mnew; lrun *= alpha; \
                _Pragma("unroll") for (int r = 0; r < 16; ++r) { o0[r] *= alpha; o1[r] *= alpha; } } \
            { const f32x2 m2 = (f32x2){mrun, mrun}; f32x2 ls2 = (f32x2){0.f, 0.f}; \
              _Pragma("unroll") for (int r = 0; r < 16; r += 2) { \
                  f32x2 a_ = (f32x2){s0[r], s0[r + 1]} - m2, b_ = (f32x2){s1[r], s1[r + 1]} - m2; \
                  a_.x = __builtin_amdgcn_exp2f(a_.x); a_.y = __builtin_amdgcn_exp2f(a_.y); b_.x = __builtin_amdgcn_exp2f(b_.x); b_.y = __builtin_amdgcn_exp2f(b_.y); \
                  s0[r] = a_.x; s0[r + 1] = a_.y; s1[r] = b_.x; s1[r + 1] = b_.y; ls2 += a_; ls2 += b_; } \
              lrun += ls2.x + ls2.y; } \
            _Pragma("unroll") for (int jj = 0; jj < 2; ++jj) { \
                u32x4 w0, w1; \
                w0.x = cvt_pk_bf16(s0[8 * jj + 0], s0[8 * jj + 1]); w0.y = cvt_pk_bf16(s0[8 * jj + 2], s0[8 * jj + 3]); w0.z = cvt_pk_bf16(s0[8 * jj + 4], s0[8 * jj + 5]); w0.w = cvt_pk_bf16(s0[8 * jj + 6], s0[8 * jj + 7]); \
                w1.x = cvt_pk_bf16(s1[8 * jj + 0], s1[8 * jj + 1]); w1.y = cvt_pk_bf16(s1[8 * jj + 2], s1[8 * jj + 3]); w1.z = cvt_pk_bf16(s1[8 * jj + 4], s1[8 * jj + 5]); w1.w = cvt_pk_bf16(s1[8 * jj + 6], s1[8 * jj + 7]); \
                pb[0][jj] = __builtin_bit_cast(bf16x8, w0); pb[1][jj] = __builtin_bit_cast(bf16x8, w1); } \
        } while (0)
#define ATT_PV(bf_) do { \
            const LAS unsigned char* vb = lds + OFF_V + (bf_) * VBUF + q32 * VSTR + hi * 16; \
            bf16x8 vfa[4], vfb[4]; \
            _Pragma("unroll") for (int xj = 0; xj < 4; ++xj) { vfa[xj] = *(const LAS bf16x8*)(vb + 32 * xj); vfb[xj] = *(const LAS bf16x8*)(vb + 32 * VSTR + 32 * xj); } \
            _Pragma("unroll") for (int x = 0; x < 2; ++x) _Pragma("unroll") for (int jj = 0; jj < 2; ++jj) { \
                o0 = __builtin_amdgcn_mfma_f32_32x32x16_bf16(vfa[2 * x + jj], pb[x][jj], o0, 0, 0, 0); \
                o1 = __builtin_amdgcn_mfma_f32_32x32x16_bf16(vfb[2 * x + jj], pb[x][jj], o1, 0, 0, 0); } \
        } while (0)
        f32x16 s0, s1; bf16x8 pb[2][2];
        const bool lateg = (wave & 4) != 0;
        int cur, nxt, t2, st = 0, stp = 0; bool havep = false;
        ATT_ITER(cur); nxt = 256; if (cur != 256) ATT_ITER(nxt);
        if (cur != 256) { ATT_LOAD(A, (cur & 255)); ATT_STORE(A, 0); }
        if (nxt != 256) ATT_LOAD(B, (nxt & 255));
        __syncthreads();
        while (cur != 256) {
            { const int st1 = st == 2 ? 0 : st + 1;
              t2 = 256; if (nxt != 256) ATT_ITER(t2);
              if (t2 != 256) ATT_LOAD(A, (t2 & 255));
              if (lateg) { if (havep) ATT_PV(stp); ATT_QK(st); ATT_SM(st, cur); havep = true; stp = st; }
              else { ATT_QK(st); ATT_SM(st, cur); ATT_PV(st); }
              if (nxt != 256) ATT_STORE(B, st1);
              __syncthreads();
              cur = nxt; nxt = t2; st = st1; }
            if (cur == 256) break;
            { const int st1 = st == 2 ? 0 : st + 1;
              t2 = 256; if (nxt != 256) ATT_ITER(t2);
              if (t2 != 256) ATT_LOAD(B, (t2 & 255));
              if (lateg) { if (havep) ATT_PV(stp); ATT_QK(st); ATT_SM(st, cur); havep = true; stp = st; }
              else { ATT_QK(st); ATT_SM(st, cur); ATT_PV(st); }
              if (nxt != 256) ATT_STORE(A, st1);
              __syncthreads();
              cur = nxt; nxt = t2; st = st1; }
        }
        if (lateg && havep) ATT_PV(stp);
        __syncthreads();
        const float ltot = lrun + shflx(lrun, 32, lane);
        const float inv = 1.0f / ltot;
        bf16_t* op = O + qrow * 512 + h * 64 + 4 * hi;
#pragma unroll
        for (int i = 0; i < 4; ++i) {
            u32x2 w; w.x = cvt_pk_bf16(o0[4 * i] * inv, o0[4 * i + 1] * inv); w.y = cvt_pk_bf16(o0[4 * i + 2] * inv, o0[4 * i + 3] * inv);
            *(u32x2*)(op + 8 * i) = w;
            u32x2 w2; w2.x = cvt_pk_bf16(o1[4 * i] * inv, o1[4 * i + 1] * inv); w2.y = cvt_pk_bf16(o1[4 * i + 2] * inv, o1[4 * i + 3] * inv);
            *(u32x2*)(op + 32 + 8 * i) = w2; }
#undef ATT_LOAD
#undef ATT_STORE
#undef ATT_QK
#undef ATT_SM
#undef ATT_PV
#undef ATT_ITER
    }
}
}


constexpr int NWAVES = 8, NTHR = 512;
constexpr int LDS_BYTES = 131072 + 1024 + 4096;

typedef const Params __attribute__((address_space(4)))* KArg;
struct Ctx { int tid, lane, wave, G, c, gw, NGW; LAS unsigned char* lds; };

enum { I_X = 0, I_C, I_POS, I_WADA, I_BADA, I_N1G, I_WIN, I_AR, I_AI, I_LDT, I_BR, I_BI, I_CR, I_CI, I_SD, I_WGLU, I_BGLU, I_WAOUT, I_QNG, I_WUQ, I_KVNG, I_WUK, I_WUV, I_WBOUT, I_WOUT, I_N2G, I_WGATE, I_WUP, I_WDOWN, I_FING };

__device__ __forceinline__ void sincos_acc(double x, float& s, float& c) {
    const double rev = x * 0.15915494309189535; const double r = rev - __builtin_rint(rev);
    const float th = (float)(r * 6.283185307179586);
    s = sinf(th); c = cosf(th);
}
__device__ __forceinline__ float inv_freq_tab(int i) {
    switch (i) { case 0: return 1.0f; case 1: return 0.5623413324356079f; case 2: return 0.3162277638912201f; case 3: return 0.17782793939113617f; case 4: return 0.10000000149011612f;
    case 5: return 0.05623413249850273f; case 6: return 0.03162277489900589f; case 7: return 0.017782794311642647f; case 8: return 0.009999999776482582f; case 9: return 0.005623413249850273f;
    case 10: return 0.003162277629598975f; case 11: return 0.0017782794311642647f; case 12: return 0.0010000000474974513f; case 13: return 0.000562341301701963f; case 14: return 0.0003162277571391314f;
    default: return 0.00017782794020604342f; }
}
__device__ __forceinline__ void p0_mod(const Ctx& X, KArg P) {
    LAS float* sc = (LAS float*)X.lds;
    LAS float* red = sc + 2048;
    const float* cin = P->in[I_C];
    for (int i = X.tid; i < 2048; i += NTHR) { const float v = cin[i]; sc[i] = v * sigmoidf_(v); }
    __syncthreads();
    float* mod = (float*)(P->ws + WS_MOD);
    for (int unit = X.c; unit < DEPTH * 96; unit += X.G) {
        const int l = unit / 96, cb = unit % 96, kp = X.tid >> 6, cj = X.tid & 63, col = cb * 64 + cj;
        const float* w = P->in[I_WADA] + ((size_t)l * 1024 + kp * 128) * 6144 + col;
        float a0 = 0.f, a1 = 0.f;
#pragma unroll 8
        for (int k = 0; k < 128; ++k) { const float wv = w[(size_t)k * 6144]; a0 += sc[kp * 128 + k] * wv; a1 += sc[1024 + kp * 128 + k] * wv; }
        red[(kp * 64 + cj) * 2] = a0; red[(kp * 64 + cj) * 2 + 1] = a1;
        __syncthreads();
        if (X.tid < 128) { const int b = X.tid >> 6, cj2 = X.tid & 63; float s = 0.f;
#pragma unroll
            for (int q = 0; q < 8; ++q) s += red[(q * 64 + cj2) * 2 + b];
            mod[((size_t)l * 2 + b) * 6144 + cb * 64 + cj2] = s + P->in[I_BADA][(size_t)l * 6144 + cb * 64 + cj2]; }
        __syncthreads();
    }
}
__device__ __forceinline__ void p0_tables(const Ctx& X, KArg P) {
    const int* pos = (const int*)P->in[I_POS];
    float* cosT = (float*)(P->ws + WS_ROPE); float* sinT = cosT + (size_t)T * 16;
    for (int idx = X.c * NTHR + X.tid; idx < T * 16; idx += X.G * NTHR) {
        const int tok = idx >> 4, i = idx & 15;
        const float ang = (float)pos[tok] * inv_freq_tab(i);
        float s, c; sincos_acc((double)ang, s, c);
        cosT[idx] = c; sinT[idx] = s;
    }
    int* tmin = (int*)(P->ws + WS_TPOS); int* tmax = tmin + 512;
    for (int t = X.gw; t < 512; t += X.NGW) {
        int v = pos[t * 64 + X.lane], mn = v, mx = v;
#pragma unroll
        for (int o = 1; o < 64; o <<= 1) { mn = min(mn, shflxi(mn, o, X.lane)); mx = max(mx, shflxi(mx, o, X.lane)); }
        if (X.lane == 0) { tmin[t] = mn; tmax[t] = mx; }
    }
}
__device__ __forceinline__ void ssm_stage1(const Ctx& X, KArg P, int l) {
    const float* a_re = P->in[I_AR] + (size_t)l * NG * SP; const float* a_im = P->in[I_AI] + (size_t)l * NG * SP; const float* ldt = P->in[I_LDT] + (size_t)l * NG;
    f32x2* apow = (f32x2*)(P->ws + WS_APOW); f32x2* bbar = (f32x2*)(P->ws + WS_BBAR);
    for (int idx = X.c * NTHR + X.tid; idx < NG * 66 * 64; idx += X.G * NTHR) {
        const int g = idx / (66 * 64), j = (idx >> 6) % 66, p = idx & 63;
        const float n = (j == 65) ? 2048.0f : (float)j;
        const float dt = expf(ldt[g]), ar = a_re[g * 64 + p], ai = a_im[g * 64 + p];
        const float mag = expf(ar * dt * n); float s, c; sincos_acc((double)ai * (double)dt * (double)n, s, c);
        apow[idx] = (f32x2){mag * c, mag * s};
    }
    const float* b_re = P->in[I_BR] + (size_t)l * NG * SP * 16; const float* b_im = P->in[I_BI] + (size_t)l * NG * SP * 16;
    for (int idx = X.c * NTHR + X.tid; idx < NG * 64 * 16; idx += X.G * NTHR) {
        const int g = idx >> 10, p = (idx >> 4) & 63;
        const float dt = expf(ldt[g]), ar = a_re[g * 64 + p], ai = a_im[g * 64 + p];
        const float mag = expf(ar * dt); float s, c; sincos_acc((double)ai * (double)dt, s, c);
        const float nr = mag * c - 1.0f, ni = mag * s, den = ar * ar + ai * ai;
        const float cr = (nr * ar + ni * ai) / den, ci = (ni * ar - nr * ai) / den;
        const float br = b_re[idx], bi = b_im[idx];
        bbar[idx] = (f32x2){cr * br - ci * bi, cr * bi + ci * br};
    }
}
__device__ __forceinline__ void ssm_stage2(const Ctx& X, KArg P, int l) {
    const f32x2* apow = (const f32x2*)(P->ws + WS_APOW); const f32x2* bbar = (const f32x2*)(P->ws + WS_BBAR);
    const float* c_re = P->in[I_CR] + (size_t)l * NG * 16 * SP; const float* c_im = P->in[I_CI] + (size_t)l * NG * 16 * SP;
    bf16_t* Kg = (bf16_t*)(P->ws + WS_KG); bf16_t* Et = (bf16_t*)(P->ws + WS_ET); bf16_t* Ft = (bf16_t*)(P->ws + WS_FT);
    for (int idx = X.c * NTHR + X.tid; idx < NG * 128 * 64; idx += X.G * NTHR) {
        const int g = idx >> 13, jj = (idx >> 6) & 127, m = (idx >> 2) & 15, mq = idx & 3;
        f32x4 acc = (f32x4){0.f, 0.f, 0.f, 0.f};
        if (jj >= 64) { const int j = jj - 64;
            const float* cr = c_re + (g * 16 + m) * 64; const float* ci = c_im + (g * 16 + m) * 64; const f32x2* ap = apow + (g * 66 + j) * 64; const f32x4* bb = (const f32x4*)(bbar + (size_t)g * 1024 + 4 * mq);
#pragma unroll 4
            for (int p = 0; p < 64; ++p) { const f32x2 a = ap[p]; const f32x4 b01 = bb[p * 8], b23 = bb[p * 8 + 1]; const float wr = cr[p] * a.x - ci[p] * a.y, wi = cr[p] * a.y + ci[p] * a.x;
                acc[0] += wr * b01[0] - wi * b01[1]; acc[1] += wr * b01[2] - wi * b01[3]; acc[2] += wr * b23[0] - wi * b23[1]; acc[3] += wr * b23[2] - wi * b23[3]; } }
        u32x2 w; w.x = cvt_pk_bf16(acc[0], acc[1]); w.y = cvt_pk_bf16(acc[2], acc[3]);
        *(u32x2*)(Kg + (size_t)idx * 4) = w;
    }
    for (int idx = X.c * NTHR + X.tid; idx < NG * 1024 * 128; idx += X.G * NTHR) {
        const int g = idx >> 17, n = (idx >> 7) & 1023, k = idx & 127, t = n >> 4, m = n & 15, p = k & 63;
        const f32x2 a = apow[(g * 66 + t + 1) * 64 + p]; const float cr = c_re[(g * 16 + m) * 64 + p], ci = c_im[(g * 16 + m) * 64 + p];
        const float wr = cr * a.x - ci * a.y, wi = cr * a.y + ci * a.x;
        Et[idx] = f2bf(k < 64 ? wr : -wi);
    }
    for (int idx = X.c * NTHR + X.tid; idx < NG * 128 * 1024; idx += X.G * NTHR) {
        const int g = idx >> 17, n = (idx >> 10) & 127, k = idx & 1023, s = k >> 4, mp = k & 15, p = n & 63;
        const f32x2 a = apow[(g * 66 + 63 - s) * 64 + p], b2 = bbar[(size_t)g * 1024 + p * 16 + mp];
        Ft[idx] = f2bf(n < 64 ? (a.x * b2.x - a.y * b2.y) : (a.x * b2.y + a.y * b2.x));
    }
}
struct SrcCol { const float* p; int ld; };
__device__ __forceinline__ SrcCol src_col(KArg P, int l, int mat, int n) {
    SrcCol r; r.p = nullptr; r.ld = 0;
    switch (mat) {
    case 0: { int s = -1; if (n < 896) s = n; else if (n < 928) { const int i = n - 896; s = 896 + (i >> 1) + (i & 1) * 16; } else if (n < 1024) s = -1; else if (n < 2048) s = 928 + (n - 1024); else s = 1952 + (n - 2048);
              r.ld = INC; if (s >= 0) r.p = P->in[I_WIN] + (size_t)l * 1024 * INC + s; } break;
    case 1: r.ld = 512; r.p = P->in[I_WGLU] + (size_t)l * 512 * 512 + n; break;
    case 2: r.ld = 1024; r.p = P->in[I_WAOUT] + (size_t)l * 512 * 1024 + n; break;
    case 3: r.ld = 1024; r.p = P->in[I_WBOUT] + (size_t)l * 512 * 1024 + n; break;
    case 4: { const int h = n / 96, d = n - h * 96; int s = n; if (d >= 64) { const int i = d - 64; s = h * 96 + 64 + (i >> 1) + (i & 1) * 16; }
              r.ld = 768; r.p = P->in[I_WUQ] + (size_t)l * 256 * 768 + s; } break;
    case 5: r.ld = 512; r.p = P->in[I_WUK] + (size_t)l * 128 * 512 + n; break;
    case 6: r.ld = 512; r.p = P->in[I_WUV] + (size_t)l * 128 * 512 + n; break;
    case 7: r.ld = 1024; r.p = P->in[I_WOUT] + (size_t)l * 1024 * 1024 + n; break;
    case 8: { const int g8 = n >> 3, q = n & 7; r.ld = DFF; r.p = (q < 4 ? P->in[I_WGATE] + (size_t)l * 1024 * DFF + 4 * g8 + q : P->in[I_WUP] + (size_t)l * 1024 * DFF + 4 * g8 + (q - 4)); } break;
    default: r.ld = 1024; r.p = P->in[I_WDOWN] + (size_t)l * DFF * 1024 + n; break;
    }
    return r;
}
template <int MAT, int K, int N>
__device__ __forceinline__ void weights_mat(const Ctx& X, KArg P, int l, bf16_t* Wdst, LAS float* scr, int base) {
    constexpr int nblk = N / 32, items = (K / 64) * nblk;
    const int first = ((X.gw - base) % X.NGW + X.NGW) % X.NGW;
    for (int it = first; it < items; it += X.NGW) {
        const int kb = it / nblk, nb = it % nblk, k0 = 64 * kb, n0 = 32 * nb;
        const SrcCol sc = src_col(P, l, MAT, n0 + (X.lane & 31));
#pragma unroll 32
        for (int i = 0; i < 32; ++i) { const int kk = 2 * i + (X.lane >> 5); scr[kk * 33 + (X.lane & 31)] = sc.p ? sc.p[(size_t)(k0 + kk) * sc.ld] : 0.f; }
        asm volatile("s_waitcnt lgkmcnt(0)" ::: "memory");
        const int ck = X.lane & 7;
#pragma unroll
        for (int j = 0; j < 4; ++j) { const int n = (X.lane >> 3) + 8 * j; const LAS float* s = scr + (8 * ck) * 33 + n;
            u32x4 o; o.x = cvt_pk_bf16(s[0], s[33]); o.y = cvt_pk_bf16(s[2 * 33], s[3 * 33]); o.z = cvt_pk_bf16(s[4 * 33], s[5 * 33]); o.w = cvt_pk_bf16(s[6 * 33], s[7 * 33]);
            *(u32x4*)(Wdst + (size_t)(n0 + n) * K + k0 + 8 * ck) = o; }
        asm volatile("s_waitcnt lgkmcnt(0)" ::: "memory");
    }
}
__device__ __forceinline__ void weights_phase(const Ctx& X, KArg P, int l) {
    bf16_t* W = (bf16_t*)(P->ws + WS_W);
    LAS float* scr = (LAS float*)(X.lds + X.wave * 8448);
    constexpr int I0 = 16 * 96, I1 = 8 * 16, I2 = 8 * 32, I3 = 8 * 32, I4 = 4 * 24, I5 = 2 * 16, I6 = 2 * 16, I7 = 16 * 32, I8 = 16 * 176;
    weights_mat<0, 1024, 3072>(X, P, l, W + WO_IN, scr, 0);
    weights_mat<1, 512, 512>(X, P, l, W + WO_GLU, scr, I0);
    weights_mat<2, 512, 1024>(X, P, l, W + WO_A, scr, I0 + I1);
    weights_mat<3, 512, 1024>(X, P, l, W + WO_B, scr, I0 + I1 + I2);
    weights_mat<4, 256, 768>(X, P, l, W + WO_UQ, scr, I0 + I1 + I2 + I3);
    weights_mat<5, 128, 512>(X, P, l, W + WO_UK, scr, I0 + I1 + I2 + I3 + I4);
    weights_mat<6, 128, 512>(X, P, l, W + WO_UV, scr, I0 + I1 + I2 + I3 + I4 + I5);
    weights_mat<7, 1024, 1024>(X, P, l, W + WO_OUT, scr, I0 + I1 + I2 + I3 + I4 + I5 + I6);
    weights_mat<8, 1024, 5632>(X, P, l, W + WO_GU, scr, I0 + I1 + I2 + I3 + I4 + I5 + I6 + I7);
    weights_mat<9, DFF, 1024>(X, P, l, W + WO_DOWN, scr, I0 + I1 + I2 + I3 + I4 + I5 + I6 + I7 + I8);
}
__device__ __forceinline__ void norm_phase(const Ctx& X, const float* x, const float* gain, const float* mod_sh, const float* mod_sc, bf16_t* h) {
    for (int row0 = X.gw; row0 < T; row0 += 2 * X.NGW) {
        const int row1 = row0 + X.NGW;
        const bool has1 = row1 < T;
        const f32x4* xr0 = (const f32x4*)(x + (size_t)row0 * 1024) + X.lane;
        const f32x4* xr1 = (const f32x4*)(x + (size_t)(has1 ? row1 : row0) * 1024) + X.lane;
        f32x4 v0[4], v1[4]; float ss0 = 0.f, ss1 = 0.f;
#pragma unroll
        for (int j = 0; j < 4; ++j) { v0[j] = xr0[64 * j]; v1[j] = xr1[64 * j]; }
#pragma unroll
        for (int j = 0; j < 4; ++j) { ss0 += (v0[j][0] * v0[j][0] + v0[j][1] * v0[j][1]) + (v0[j][2] * v0[j][2] + v0[j][3] * v0[j][3]);
                                      ss1 += (v1[j][0] * v1[j][0] + v1[j][1] * v1[j][1]) + (v1[j][2] * v1[j][2] + v1[j][3] * v1[j][3]); }
#pragma unroll
        for (int o = 1; o < 64; o <<= 1) { ss0 += shflx(ss0, o, X.lane); ss1 += shflx(ss1, o, X.lane); }
        const float r0 = rsqrtf(ss0 * (1.0f / 1024.0f) + EPS), r1 = rsqrtf(ss1 * (1.0f / 1024.0f) + EPS);
        const int bo0 = row0 >= SEQ ? 6144 : 0, bo1 = row1 >= SEQ ? 6144 : 0;
#pragma unroll
        for (int j = 0; j < 4; ++j) { const int col = 256 * j + 4 * X.lane;
            const f32x4 g4 = *(const f32x4*)(gain + col);
            { const f32x4 s4 = *(const f32x4*)(mod_sc + bo0 + col), h4 = *(const f32x4*)(mod_sh + bo0 + col);
              const f32x4 o = v0[j] * r0 * g4 * (s4 + 1.0f) + h4; u32x2 w; w.x = cvt_pk_bf16(o[0], o[1]); w.y = cvt_pk_bf16(o[2], o[3]);
              *(u32x2*)(h + (size_t)row0 * 1024 + col) = w; }
            if (has1) { const f32x4 s4 = *(const f32x4*)(mod_sc + bo1 + col), h4 = *(const f32x4*)(mod_sh + bo1 + col);
              const f32x4 o = v1[j] * r1 * g4 * (s4 + 1.0f) + h4; u32x2 w; w.x = cvt_pk_bf16(o[0], o[1]); w.y = cvt_pk_bf16(o[2], o[3]);
              *(u32x2*)(h + (size_t)row1 * 1024 + col) = w; } }
    }
}
__device__ __forceinline__ void final_norm_phase(const Ctx& X, float* x, const float* gain) {
    for (int row = X.gw; row < T; row += X.NGW) {
        f32x4* xr = (f32x4*)(x + (size_t)row * 1024) + X.lane;
        f32x4 v[4]; float ss = 0.f;
#pragma unroll
        for (int j = 0; j < 4; ++j) { v[j] = xr[64 * j]; ss += (v[j][0] * v[j][0] + v[j][1] * v[j][1]) + (v[j][2] * v[j][2] + v[j][3] * v[j][3]); }
        const float r = rsqrtf(wave_sum(ss, X.lane) * (1.0f / 1024.0f) + EPS);
#pragma unroll
        for (int j = 0; j < 4; ++j) { const f32x4 g4 = *(const f32x4*)(gain + 256 * j + 4 * X.lane); xr[64 * j] = v[j] * r * g4; }
    }
}
__device__ __forceinline__ void prep_phase(const Ctx& X, KArg P, int l) {
    bf16_t* zx = (bf16_t*)(P->ws + WS_ZX); bf16_t* Kpe = (bf16_t*)(P->ws + WS_KPE);
    const float* cosT = (const float*)(P->ws + WS_ROPE); const float* sinT = cosT + (size_t)T * 16;
    const float* qg = P->in[I_QNG] + (size_t)l * QL; const float* kg = P->in[I_KVNG] + (size_t)l * KVL;
    for (int row = X.gw; row < T; row += X.NGW) {
        bf16_t* zr = zx + (size_t)row * 512;
        const u32x2 cq = *(const u32x2*)(zr + 4 * X.lane); const unsigned ck = *(const unsigned*)(zr + 256 + 2 * X.lane);
        const float q0 = bflo(cq.x), q1 = bfhi(cq.x), q2 = bflo(cq.y), q3 = bfhi(cq.y), k0 = bflo(ck), k1 = bfhi(ck);
        const float rq = rsqrtf(wave_sum((q0 * q0 + q1 * q1) + (q2 * q2 + q3 * q3), X.lane) * (1.0f / 256.0f) + EPS);
        const float rk = rsqrtf(wave_sum(k0 * k0 + k1 * k1, X.lane) * (1.0f / 128.0f) + EPS);
        const f32x4 g4 = *(const f32x4*)(qg + 4 * X.lane); const f32x2 g2 = *(const f32x2*)(kg + 2 * X.lane);
        u32x2 wq; wq.x = cvt_pk_bf16(q0 * rq * g4[0], q1 * rq * g4[1]); wq.y = cvt_pk_bf16(q2 * rq * g4[2], q3 * rq * g4[3]);
        const unsigned wk = cvt_pk_bf16(k0 * rk * g2[0], k1 * rk * g2[1]);
        if (X.lane < 16) { const unsigned kr = *(const unsigned*)(zr + 384 + 2 * X.lane); const float x1 = bflo(kr), x2 = bfhi(kr);
            const float c = cosT[(size_t)row * 16 + X.lane], s = sinT[(size_t)row * 16 + X.lane];
            *(unsigned*)(Kpe + (size_t)row * 32 + 2 * X.lane) = cvt_pk_bf16(x1 * c - x2 * s, x2 * c + x1 * s); }
        *(u32x2*)(zr + 4 * X.lane) = wq; *(unsigned*)(zr + 256 + 2 * X.lane) = wk;
    }
}
__device__ __forceinline__ void carry_phase(const Ctx& X, KArg P) {
    const float* S = (const float*)(P->ws + WS_S); bf16_t* Hc = (bf16_t*)(P->ws + WS_HC); const f32x2* apow = (const f32x2*)(P->ws + WS_APOW);
    LAS f32x2* Ew = (LAS f32x2*)X.lds;
    const int cshift = X.G >= 64 ? X.G - 64 : 0;
    for (int i = X.c - cshift; i < 64; i += X.G) {
        if (i < 0) break;
        const int b = i >> 5, g = i & 31, p = X.lane, w = X.wave;
        const f32x2 a64 = apow[(g * 66 + 64) * 64 + p], a2k = apow[(g * 66 + 65) * 64 + p];
        const size_t r0 = ((size_t)g * NCH + b * 256 + w * 32) * 128;
        float sre[32], sim[32];
#pragma unroll
        for (int cc = 0; cc < 32; ++cc) { sre[cc] = S[r0 + cc * 128 + p]; sim[cc] = S[r0 + cc * 128 + 64 + p]; }
        float hr = 0.f, hi = 0.f;
#pragma unroll
        for (int cc = 0; cc < 32; ++cc) { const float nr = a64.x * hr - a64.y * hi + sre[cc], ni = a64.x * hi + a64.y * hr + sim[cc]; hr = nr; hi = ni; }
        Ew[w * 64 + p] = (f32x2){hr, hi};
        __syncthreads();
        hr = 0.f; hi = 0.f;
        for (int q = 0; q < w; ++q) { const f32x2 e = Ew[q * 64 + p]; const float nr = a2k.x * hr - a2k.y * hi + e.x, ni = a2k.x * hi + a2k.y * hr + e.y; hr = nr; hi = ni; }
#pragma unroll
        for (int cc = 0; cc < 32; ++cc) {
            Hc[r0 + cc * 128 + p] = f2bf(hr); Hc[r0 + cc * 128 + 64 + p] = f2bf(hi);
            const float nr = a64.x * hr - a64.y * hi + sre[cc], ni = a64.x * hi + a64.y * hr + sim[cc]; hr = nr; hi = ni; }
        __syncthreads();
    }
}

#ifndef PHMASK
#define PHMASK 0xffffffffu
#endif
__global__ void __launch_bounds__(NTHR, 2) trunk_fwd(Params Pval) {
    extern __shared__ __attribute__((aligned(16))) unsigned char lds_raw[];
    cg::grid_group grid = cg::this_grid();
    Ctx X; X.lds = (LAS unsigned char*)lds_raw; X.tid = threadIdx.x; X.lane = X.tid & 63; X.wave = __builtin_amdgcn_readfirstlane(X.tid >> 6);
    X.G = gridDim.x; X.c = blockIdx.x; X.gw = X.c * NWAVES + X.wave; X.NGW = X.G * NWAVES;
    using pg8::Gemm; using pg8::Order;
    KArg P = (KArg)__builtin_amdgcn_kernarg_segment_ptr();
    unsigned char* ws;
    unsigned bar_epoch = 0;
#ifdef PROBE_PHASE
    unsigned long long probe_acc = 0, probe_t = 0; int probe_seg = -1;
#define PROBE_TICK() do { const unsigned long long now_ = __builtin_amdgcn_s_memrealtime(); if (probe_seg >= 0 && probe_seg < 16 && ((PROBE_PHASE >> probe_seg) & 1)) probe_acc += now_ - probe_t; probe_t = now_; ++probe_seg; } while (0)
#else
#define PROBE_TICK() do {} while (0)
#endif
    const unsigned my_xcc = (unsigned)__builtin_amdgcn_s_getreg((3 << 11) | 20) & 0xFu;
    volatile LAS unsigned* const bar_lds = (volatile LAS unsigned*)(X.lds + 131072);
#define BAR_LD(p) __hip_atomic_load((p), __ATOMIC_RELAXED, __HIP_MEMORY_SCOPE_AGENT)
#define BAR_ADD(p, v) __hip_atomic_fetch_add((p), (v), __ATOMIC_RELAXED, __HIP_MEMORY_SCOPE_AGENT)
    {
        unsigned* const bw = (unsigned*)(P->ws + WS_BAR);
        if (X.tid == 0) { BAR_ADD(bw + 64 * my_xcc, 1u); BAR_ADD(bw + 3200, 1u); while (BAR_LD(bw + 3200) < (unsigned)X.G) __builtin_amdgcn_s_sleep(1);
            unsigned nl = 1, nxc = 0;
            for (unsigned j = 0; j < 16; ++j) { const unsigned cj = BAR_LD(bw + 64 * j); if (cj) ++nxc; if (j == my_xcc) nl = cj; }
            bar_lds[0] = nl; bar_lds[1] = nxc ? nxc : 1u; }
        __syncthreads();
    }
#define GRID_SYNC() do { asm volatile("s_waitcnt vmcnt(0)" ::: "memory"); __syncthreads(); \
        asm volatile("" : "+s"(P)); unsigned* const bw_ = (unsigned*)(P->ws + WS_BAR); \
        unsigned lb_ = (unsigned)(size_t)X.lds + 131072u; asm volatile("" : "+s"(lb_)); unsigned xc_ = my_xcc; asm volatile("" : "+s"(xc_)); \
        if (X.tid == 0) { const unsigned nl_ = ((volatile LAS unsigned*)lb_)[0], nx_ = ((volatile LAS unsigned*)lb_)[1], k_ = bar_epoch; \
            const unsigned old_ = BAR_ADD(bw_ + 1024 + 64 * xc_, 1u); \
            if (old_ + 1u == (k_ + 1u) * nl_) { __builtin_amdgcn_fence(__ATOMIC_RELEASE, "agent"); asm volatile("s_waitcnt vmcnt(0)" ::: "memory"); \
                const unsigned og_ = BAR_ADD(bw_ + 3072, 1u); \
                if (og_ + 1u == (k_ + 1u) * nx_) BAR_ADD(bw_ + 3136, 1u); else while (BAR_LD(bw_ + 3136) <= k_) __builtin_amdgcn_s_sleep(1); \
                __builtin_amdgcn_fence(__ATOMIC_ACQUIRE, "agent"); BAR_ADD(bw_ + 2048 + 64 * xc_, 1u); asm volatile("s_waitcnt vmcnt(0)" ::: "memory"); } \
            else { while (BAR_LD(bw_ + 2048 + 64 * xc_) <= k_) __builtin_amdgcn_s_sleep(1); __builtin_amdgcn_fence(__ATOMIC_ACQUIRE, "agent"); asm volatile("s_waitcnt vmcnt(0)" ::: "memory"); } } \
        bar_epoch += 1; __syncthreads(); PROBE_TICK(); } while (0)
#define FRESH() do { asm volatile("" : "+s"(P)); asm volatile("v_mbcnt_lo_u32_b32 %0, -1, 0\n\tv_mbcnt_hi_u32_b32 %0, -1, %0" : "=v"(X.lane)); X.tid = X.wave * 64 + X.lane; ws = P->ws; } while (0)
#define mod ((float*)(ws + WS_MOD))
#define cosT ((const float*)(ws + WS_ROPE))
#define sinT (cosT + (size_t)T * 16)
#define tmin ((const int*)(ws + WS_TPOS))
#define tmax (tmin + 512)
#define Wb ((bf16_t*)(ws + WS_W))
#define Hb ((bf16_t*)(ws + WS_H))
#define Ug ((bf16_t*)(ws + WS_UG))
#define zx ((bf16_t*)(ws + WS_ZX))
#define gates ((bf16_t*)(ws + WS_GATES))
#define Qb ((bf16_t*)(ws + WS_Q))
#define Kn ((bf16_t*)(ws + WS_KN))
#define Kpe ((bf16_t*)(ws + WS_KPE))
#define Vt ((bf16_t*)(ws + WS_VT))
#define Ob ((bf16_t*)(ws + WS_O))
#define ypart ((bf16_t*)(ws + WS_YPART))
#define ya ((bf16_t*)(ws + WS_YA))
#define yg ((bf16_t*)(ws + WS_YG))
#define hid ((bf16_t*)(ws + WS_HID))
#define Sb ((float*)(ws + WS_S))
#define Hc ((bf16_t*)(ws + WS_HC))
#define modl (mod + (size_t)l * 2 * 6144)
#define xin ((l == 0) ? P->in[I_X] : (const float*)P->out)

#define PH(n) if (PHMASK & (1u << (n)))
    grid.sync();
    PH(0) { FRESH(); p0_mod(X, P); p0_tables(X, P); weights_phase(X, P, 0); ssm_stage1(X, P, 0); }
    GRID_SYNC();

    for (int l = 0; l < DEPTH; ++l) {
#ifdef PROBE_PHASE
        probe_seg = 0;
#endif
        if (l > 0) PH(1) { FRESH(); weights_phase(X, P, l); ssm_stage1(X, P, l); }
        PH(2) { FRESH(); norm_phase(X, xin, P->in[I_N1G] + (size_t)l * 1024, modl + 0, modl + 1024, Hb); }
        GRID_SYNC();
        PH(3) { FRESH(); ssm_stage2(X, P, l); }
        PH(4) { FRESH(); Gemm g{Hb, Wb + WO_IN, 1024, 1024, 0, 0, 1024}; Order S; S.init(T, 3072, 1, X.G, X.c); pg8::EpiIn E{Ug, zx, gates, Kpe, P->in[I_QNG] + (size_t)l * QL, P->in[I_KVNG] + (size_t)l * KVL, cosT, sinT, X.lds};
          pg8::gemm_phase<pg8::EpiIn, false>(X.lds, g, S, E, X.tid); }
        GRID_SYNC();
        PH(6) { FRESH(); Gemm g{Ug, (const bf16_t*)(ws + WS_FT), 1024, 1024, (size_t)NCH * 1024, (size_t)128 * 1024, 1024}; Order S; S.init(NCH, 256, NG, X.G, X.c); pg8::EpiS E{Sb};
          pg8::gemm_phase<pg8::EpiS, false>(X.lds, g, S, E, X.tid); }
        GRID_SYNC();
        PH(7) { FRESH(); carry_phase(X, P); }
        PH(8) { FRESH(); Gemm g{zx, Wb + WO_UQ, 512, 256, 0, 0, 256}; Order S; S.init(T, 768, 1, X.G, X.c); pg8::EpiQ E{Qb, cosT, sinT, 0.10206207261596577f * 1.4426950408889634f};
          pg8::gemm_phase<pg8::EpiQ, false>(X.lds, g, S, E, X.tid); }
        PH(9) { FRESH(); Gemm g{zx + 256, Wb + WO_UK, 512, 128, 0, 0, 128}; Order S; S.init(T, 512, 1, X.G, X.c); pg8::EpiStore E{Kn, 0, 512};
          pg8::gemm_phase<pg8::EpiStore, false>(X.lds, g, S, E, X.tid); }
        PH(10) { FRESH(); Gemm g{Wb + WO_UV, zx + 256, 128, 512, 0, 0, 128}; Order S; S.init(512, T, 1, X.G, X.c); pg8::EpiStore E{Vt, 0, T};
          pg8::gemm_phase<pg8::EpiStore, false>(X.lds, g, S, E, X.tid); }
        GRID_SYNC();
#ifdef ATT_DUMMY
        PH(11) { FRESH(); for (int idx = X.c * NTHR + X.tid; idx < T * 512; idx += X.G * NTHR) { const int row = idx >> 9, cc = idx & 511, h = cc >> 6, d = cc & 63;
            const float v = bf2f(Qb[(size_t)row * 768 + h * 96 + d]) + bf2f(Qb[(size_t)row * 768 + h * 96 + 64 + (d & 31)]) + bf2f(Kn[(size_t)row * 512 + cc]) + bf2f(Vt[(size_t)cc * T + row]) + bf2f(Kpe[(size_t)row * 32 + (d & 31)]);
            Ob[idx] = f2bf(v * 0.25f); } }
#else
        PH(11) { FRESH(); att::phase(X.lds, Qb, Kn, Kpe, Vt, Ob, (const int*)P->in[I_POS], tmin, tmax, X.G, X.c, X.tid); }
#endif
#ifdef SYNC_AFTER_ATT
        GRID_SYNC();
#endif
        PH(12) { FRESH(); Gemm g{Ug, (const bf16_t*)(ws + WS_KG) + 16384, 1024, 16, (size_t)NCH * 1024, 32768, 1024}; Order S; S.init(NCH, 1024, NG, X.G, X.c); pg8::EpiStore E{ypart, (size_t)NCH * 1024, 1024};
          pg8::gemm_phase<pg8::EpiStore, true>(X.lds, g, S, E, X.tid); }
        PH(13) { FRESH(); Gemm g{Hc, (const bf16_t*)(ws + WS_ET), 128, 128, (size_t)NCH * 128, (size_t)1024 * 128, 128}; Order S; S.init(NCH, 1024, NG, X.G, X.c);
          pg8::EpiE E{ypart, Ug, P->in[I_SD] + (size_t)l * SW, ya};
          pg8::gemm_phase<pg8::EpiE, false>(X.lds, g, S, E, X.tid); }
        GRID_SYNC();
        PH(14) { FRESH(); Gemm g{ya, Wb + WO_GLU, 512, 512, 0, 0, 512}; Order S; S.init(T, 512, 1, X.G, X.c); pg8::EpiGlu E{ya, P->in[I_BGLU] + (size_t)l * SW, yg};
          pg8::gemm_phase<pg8::EpiGlu, false>(X.lds, g, S, E, X.tid); }
        GRID_SYNC();
        if ((512 % X.G) == 0) {
        PH(15) { FRESH(); Gemm g{yg, Wb + WO_A, 512, 512, (size_t)(WS_O - WS_YG) / 2, (size_t)(WO_B - WO_A), 512}; Order S; S.init(T, 1024, 2, X.G, X.c); pg8::EpiMerge2 E{gates, Hb};
          pg8::gemm_phase<pg8::EpiMerge2, false>(X.lds, g, S, E, X.tid); }
        } else {
        PH(15) { FRESH(); Gemm g{yg, Wb + WO_A, 512, 512, 0, 0, 512}; Order S; S.init(T, 1024, 1, X.G, X.c); pg8::EpiMerge<false> E{gates, 0, Hb};
          pg8::gemm_phase<pg8::EpiMerge<false>, false>(X.lds, g, S, E, X.tid); }
        GRID_SYNC();
        PH(16) { FRESH(); Gemm g{Ob, Wb + WO_B, 512, 512, 0, 0, 512}; Order S; S.init(T, 1024, 1, X.G, X.c); pg8::EpiMerge<true> E{gates, 1024, Hb};
          pg8::gemm_phase<pg8::EpiMerge<true>, false>(X.lds, g, S, E, X.tid); }
        }
        GRID_SYNC();
        PH(17) { FRESH(); Gemm g{Hb, Wb + WO_OUT, 1024, 1024, 0, 0, 1024}; Order S; S.init(T, 1024, 1, X.G, X.c); pg8::EpiRes E{xin, P->out, modl + 2048};
          pg8::gemm_phase<pg8::EpiRes, false>(X.lds, g, S, E, X.tid); }
        GRID_SYNC();
        PH(18) { FRESH(); norm_phase(X, P->out, P->in[I_N2G] + (size_t)l * 1024, modl + 3072, modl + 4096, Hb); }
        GRID_SYNC();
        PH(19) { FRESH(); Gemm g{Hb, Wb + WO_GU, 1024, 1024, 0, 0, 1024}; Order S; S.init(T, 5632, 1, X.G, X.c); pg8::EpiGU E{hid};
          pg8::gemm_phase<pg8::EpiGU, false>(X.lds, g, S, E, X.tid); }
        GRID_SYNC();
        PH(20) { FRESH(); Gemm g{hid, Wb + WO_DOWN, DFF, DFF, 0, 0, DFF}; Order S; S.init(T, 1024, 1, X.G, X.c); pg8::EpiRes E{P->out, P->out, modl + 5120};
          pg8::gemm_phase<pg8::EpiRes, false>(X.lds, g, S, E, X.tid); }
        GRID_SYNC();
    }
    PH(21) { FRESH(); final_norm_phase(X, P->out, P->in[I_FING]); }
#ifdef PROBE_PHASE
    GRID_SYNC(); if (blockIdx.x == 0 && X.tid == 0) P->out[0] = PROBE_Q * (float)(int)((float)probe_acc * 0.01f / PROBE_Q + 0.5f);
#endif
}

extern "C" void kernel_launch(void* const* d_in, const int* in_sizes, int n_in, void* d_out, int out_size, void* d_ws, size_t ws_size, hipStream_t stream) {
    static int grid_blocks = 0;
    if (grid_blocks == 0) {
        if (n_in != 30 || ws_size < WS_END) { fprintf(stderr, "kernel_launch: unexpected n_in %d / ws_size %zu (need %zu)\n", n_in, ws_size, (size_t)WS_END); grid_blocks = -1; return; }
        int dev = 0, cus = 0, per_cu = 0;
        hipGetDevice(&dev);
        hipDeviceGetAttribute(&cus, hipDeviceAttributeMultiprocessorCount, dev);
        if (hipFuncSetAttribute((const void*)trunk_fwd, hipFuncAttributeMaxDynamicSharedMemorySize, LDS_BYTES) != hipSuccess) fprintf(stderr, "kernel_launch: hipFuncSetAttribute failed\n");
        hipOccupancyMaxActiveBlocksPerMultiprocessor(&per_cu, (const void*)trunk_fwd, NTHR, LDS_BYTES);
        if (per_cu < 1) per_cu = 1;
        grid_blocks = cus * per_cu;
        fprintf(stderr, "kernel_launch: cus %d per_cu %d grid %d\n", cus, per_cu, grid_blocks);
    }
    if (grid_blocks < 0) return;
    if (hipMemsetAsync((char*)d_ws + WS_BAR, 0, 16384, stream) != hipSuccess) fprintf(stderr, "kernel_launch: memset failed\n");
    Params p{};
    for (int i = 0; i < 30; ++i) p.in[i] = (const float*)d_in[i];
    p.out = (float*)d_out; p.ws = (unsigned char*)d_ws;
    void* args[] = {&p};
    hipError_t e = hipLaunchCooperativeKernel((const void*)trunk_fwd, dim3(grid_blocks), dim3(NTHR), args, LDS_BYTES, stream);
    if (e != hipSuccess) fprintf(stderr, "cooperative launch failed: %s (grid %d)\n", hipGetErrorString(e), grid_blocks);
}
```

```cpp
#include <hip/hip_runtime.h>
#include <hip/hip_cooperative_groups.h>
#include <cstdio>
#include <cstdint>
#include <cstddef>
namespace cg = cooperative_groups;

#define LAS __attribute__((address_space(3)))
typedef unsigned short bf16_t;
typedef short bf16x8 __attribute__((ext_vector_type(8)));
typedef short s16x4 __attribute__((ext_vector_type(4)));
typedef float f32x4 __attribute__((ext_vector_type(4)));
typedef float f32x2 __attribute__((ext_vector_type(2)));
typedef float f32x16 __attribute__((ext_vector_type(16)));
typedef unsigned u32x4 __attribute__((ext_vector_type(4)));
typedef unsigned u32x2 __attribute__((ext_vector_type(2)));
typedef int i32x4 __attribute__((ext_vector_type(4)));

constexpr int D = 1024, BATCH = 2, SEQ = 16384, T = BATCH * SEQ, DEPTH = 4;
constexpr int SW = 512, NG = 32, SP = 64;
constexpr int NH = 8, QKD = 96, QL = 256, KVL = 128;
constexpr int DFF = 2816, INC = 2976;
constexpr int NCH = T / 64;
constexpr float EPS = 1e-6f;

constexpr size_t MiB = 1u << 20;
constexpr size_t WS_MOD = 0, WS_TPOS = 1 * MiB, WS_ROPE = 2 * MiB, WS_APOW = 6 * MiB, WS_BBAR = 8 * MiB, WS_KG = 9 * MiB, WS_ET = 11 * MiB, WS_FT = 19 * MiB,
                 WS_S = 28 * MiB, WS_HC = 36 * MiB, WS_W = 40 * MiB, WS_H = 68 * MiB, WS_UG = 132 * MiB, WS_ZX = 164 * MiB, WS_GATES = 196 * MiB, WS_Q = 324 * MiB,
                 WS_KN = 372 * MiB, WS_KPE = 404 * MiB, WS_VT = 406 * MiB, WS_O = 438 * MiB, WS_YPART = 470 * MiB, WS_END = 502 * MiB;
constexpr size_t WS_BAR = 1 * MiB + 65536;
constexpr size_t WS_YA = WS_ZX, WS_YG = WS_Q, WS_HID = WS_GATES;
constexpr size_t WO_IN = 0, WO_GLU = WO_IN + 3072 * 1024, WO_A = WO_GLU + 512 * 512, WO_B = WO_A + 1024 * 512, WO_UQ = WO_B + 1024 * 512, WO_UK = WO_UQ + 768 * 256,
                 WO_UV = WO_UK + 512 * 128, WO_OUT = WO_UV + 512 * 128, WO_GU = WO_OUT + 1024 * 1024, WO_DOWN = WO_GU + 5632 * 1024, WO_END = WO_DOWN + 1024 * 2816;
static_assert(WO_END * 2 <= 28 * MiB, "weight region");

struct Params {
    const float* in[30];
    float* out;
    unsigned char* ws;
};

typedef __bf16 bf16x2_t __attribute__((ext_vector_type(2)));
__device__ __forceinline__ unsigned cvt_pk_bf16(float lo, float hi) { f32x2 v = {lo, hi}; bf16x2_t b = __builtin_convertvector(v, bf16x2_t); return __builtin_bit_cast(unsigned, b); }
__device__ __forceinline__ bf16_t f2bf(float f) { unsigned u = __builtin_bit_cast(unsigned, f); return (bf16_t)((u + 0x7fffu + ((u >> 16) & 1u)) >> 16); }
__device__ __forceinline__ float bf2f(unsigned short h) { return __builtin_bit_cast(float, (unsigned)h << 16); }
__device__ __forceinline__ float bflo(unsigned w) { return __builtin_bit_cast(float, w << 16); }
__device__ __forceinline__ float bfhi(unsigned w) { return __builtin_bit_cast(float, w & 0xffff0000u); }
__device__ __forceinline__ float sigmoidf_(float x) { return __builtin_amdgcn_rcpf(1.0f + __expf(-x)); }
__device__ __forceinline__ float gelu_tanh(float x) { const float z = 1.5957691216f * (x + 0.044715f * x * x * x); return x * sigmoidf_(z); }
__device__ __forceinline__ u32x4 pack8(const f32x4 a, const f32x4 b) { u32x4 w; w.x = cvt_pk_bf16(a[0], a[1]); w.y = cvt_pk_bf16(a[2], a[3]); w.z = cvt_pk_bf16(b[0], b[1]); w.w = cvt_pk_bf16(b[2], b[3]); return w; }
__device__ __forceinline__ void unpack8(const u32x4 w, f32x4& a, f32x4& b) { a = (f32x4){bflo(w.x), bfhi(w.x), bflo(w.y), bfhi(w.y)}; b = (f32x4){bflo(w.z), bfhi(w.z), bflo(w.w), bfhi(w.w)}; }
__device__ __forceinline__ float shflx(float v, int o, int lane) { return __builtin_bit_cast(float, __builtin_amdgcn_ds_bpermute((lane ^ o) << 2, __builtin_bit_cast(int, v))); }
__device__ __forceinline__ int shflxi(int v, int o, int lane) { return __builtin_amdgcn_ds_bpermute((lane ^ o) << 2, v); }
__device__ __forceinline__ float wave_sum(float v, int lane) {
#pragma unroll
    for (int o = 1; o < 64; o <<= 1) v += shflx(v, o, lane);
    return v;
}

namespace pg8 {
constexpr int BM = 256, BK = 64, HALF = 128, HTB = HALF * BK * 2, STAGE_BYTES = 8 * HTB, NXCD = 8, WGM = 8;
__device__ __forceinline__ int lds_byte(int r, int c) { const int st = (r >> 4) * 2 + (c >> 5), rr = r & 15, cc = c & 31, ob = rr * 64 + cc * 2; return st * 1024 + (ob ^ (((ob >> 9) & 1) << 5)); }
__device__ __forceinline__ void stage_rc(int b, int& R, int& C) { const int st = b / 1024, sb = b % 1024, swz = sb ^ (((sb >> 9) & 1) << 5); R = (st >> 1) * 16 + swz / 64; C = (st & 1) * 32 + (swz % 64) / 2; }
__device__ __forceinline__ int perm32(int rho) { const int n = rho >> 4, i = rho & 15; return 8 * (i >> 2) + 4 * n + (i & 3); }

struct Unit { int g, pm, pn; };
struct Gemm { const bf16_t* A; const bf16_t* Bt; int lda, ldb; size_t gsA, gsB; int K; };

struct Order {
    int nM, nN, per, total, G, c;
    __device__ void init(int M, int N, int groups, int G_, int c_) { nM = M / BM; nN = N / BM; per = nM * nN; total = per * groups; G = G_; c = c_; }
    __device__ bool next(int i, Unit& u) const {
        const int L = i * G + c; if (L >= total) return false;
        const int grp = L / per; int wgid = L - grp * per;
        { const int q = per / NXCD, r = per % NXCD, xcd = wgid % NXCD, off = wgid / NXCD; wgid = (xcd < r ? xcd * (q + 1) : r * (q + 1) + (xcd - r) * q) + off; }
        const int nig = WGM * nN, gid = wgid / nig, fm = gid * WGM, gsz = (nM - fm) < WGM ? (nM - fm) : WGM;
        u.g = grp; u.pm = fm + ((wgid % nig) % gsz); u.pn = (wgid % nig) / gsz; return true;
    }
};

template <class Epi, bool TOEP>
__device__ __forceinline__ void gemm_phase(LAS unsigned char* lds, const Gemm g, const Order& S, const Epi& E, int tid_in) {
    int tid_ = tid_in; asm volatile("" : "+v"(tid_));
    const int tid = tid_, wid = __builtin_amdgcn_readfirstlane(tid >> 6), lane = tid & 63, wr = wid >> 2, wc = wid & 3, fr = lane & 15, fq = lane >> 4;
    const int K = g.K, nt = K / BK;
    unsigned voffA[2], voffB[2];
#pragma unroll
    for (int i = 0; i < 2; ++i) { int R, C; stage_rc(tid * 16 + i * 8192, R, C); const int Rb = (R & ~31) + perm32(R & 31);
        voffA[i] = (unsigned)(R * g.lda + C) * 2u; voffB[i] = TOEP ? (unsigned)(Rb * g.ldb + (C & 15) - (C >> 4) * 256 + 768) * 2u : (unsigned)(Rb * g.ldb + C) * 2u; }
    const ptrdiff_t kstepA = (ptrdiff_t)(BK * 2), kstepB = TOEP ? (ptrdiff_t)-2048 : (ptrdiff_t)(BK * 2);
    const ptrdiff_t hstepA = (ptrdiff_t)HALF * g.lda * 2, hstepB = (ptrdiff_t)HALF * g.ldb * 2;
    const unsigned ldsb = (unsigned)(size_t)lds + (unsigned)wid * 1024u;
    const int aoff = lds_byte(wr * 64 + fr, fq * 8), boff = lds_byte(wc * 32 + fr, fq * 8);
#define PG8_UA(u) ((const char*)g.A + ((size_t)(u).g * g.gsA + (size_t)(u).pm * BM * g.lda) * 2)
#define PG8_UB(u) ((const char*)g.Bt + ((size_t)(u).g * g.gsB + (size_t)(u).pn * BM * g.ldb) * 2 - (TOEP ? 1536 : 0))
#define PG8_SA(b, h) (((b) * 2 + (h)) * HTB)
#define PG8_SB(b, h) ((4 + (b) * 2 + (h)) * HTB)
#define PG8_STAGE(bufoff, gbase, voff) do { _Pragma("unroll") for (int _i = 0; _i < 2; ++_i) { unsigned keep_; \
        asm volatile("s_mov_b32 %0, m0\n\ts_mov_b32 m0, %3\n\ts_nop 0\n\tglobal_load_lds_dwordx4 %1, %2\n\ts_mov_b32 m0, %0" : "=&s"(keep_) : "v"((voff)[_i]), "s"((const char*)(gbase)), "s"(ldsb + (unsigned)((bufoff) + _i * 8192)) : "memory"); } } while (0)
#define PG8_LDA(dst, b, h) do { _Pragma("unroll") for (int m = 0; m < 4; ++m) _Pragma("unroll") for (int k = 0; k < 2; ++k) dst[m][k] = *(const LAS bf16x8*)(lds + PG8_SA(b, h) + aoff + m * 2048 + k * 1024); } while (0)
#define PG8_LDB(dst, b, h) do { _Pragma("unroll") for (int n = 0; n < 2; ++n) _Pragma("unroll") for (int k = 0; k < 2; ++k) dst[n][k] = *(const LAS bf16x8*)(lds + PG8_SB(b, h) + boff + n * 2048 + k * 1024); } while (0)
#define PG8_MMA(ai, bj, At, Bt) do { __builtin_amdgcn_s_setprio(1); _Pragma("unroll") for (int m = 0; m < 4; ++m) _Pragma("unroll") for (int n = 0; n < 2; ++n) _Pragma("unroll") for (int k = 0; k < 2; ++k) \
        acc[ai][bj][m][n] = __builtin_amdgcn_mfma_f32_16x16x32_bf16(Bt[n][k], At[m][k], acc[ai][bj][m][n], 0, 0, 0); __builtin_amdgcn_s_setprio(0); } while (0)
#define PG8_WAIT_V(n) asm volatile("s_waitcnt vmcnt(" #n ")" ::: "memory")
#define PG8_WAIT_L(n) asm volatile("s_waitcnt lgkmcnt(" #n ")" ::: "memory")
#define PG8_BAR __builtin_amdgcn_s_barrier()
#define PG8_SCHED __builtin_amdgcn_sched_barrier(0)
    Unit cur, nxt; int ui = 0;
    if (!S.next(0, cur)) return;
    f32x4 acc[2][2][4][2];
#pragma unroll
    for (int a = 0; a < 2; ++a)
#pragma unroll
        for (int b = 0; b < 2; ++b)
#pragma unroll
            for (int m = 0; m < 4; ++m)
#pragma unroll
                for (int n = 0; n < 2; ++n) acc[a][b][m][n] = (f32x4){0.f, 0.f, 0.f, 0.f};
    bf16x8 At[4][2], B0[2][2], B1[2][2];
    const char* cA = PG8_UA(cur); const char* cB = PG8_UB(cur);
    PG8_STAGE(PG8_SB(0, 0), cB, voffB); PG8_STAGE(PG8_SB(0, 1), cB + hstepB, voffB); PG8_STAGE(PG8_SA(0, 0), cA, voffA); PG8_STAGE(PG8_SA(0, 1), cA + hstepA, voffA);
    if (wr == 1) PG8_BAR;
    PG8_WAIT_V(2); PG8_BAR;
    PG8_STAGE(PG8_SB(1, 0), cB + kstepB, voffB); PG8_STAGE(PG8_SA(1, 0), cA + kstepA, voffA); PG8_STAGE(PG8_SB(1, 1), cB + hstepB + kstepB, voffB);
    PG8_WAIT_V(6); PG8_BAR;
    for (;;) {
        const bool has_next = S.next(ui + 1, nxt);
        const char* nA = has_next ? PG8_UA(nxt) : cA; const char* nB = has_next ? PG8_UB(nxt) : cB;
        for (int t = 0; t < nt; t += 2) {
            const bool last = (t == nt - 2);
            asm volatile("" : "+v"(voffA[0]), "+v"(voffA[1]), "+v"(voffB[0]), "+v"(voffB[1]));
            const char* a1 = cA + (ptrdiff_t)(t + 1) * kstepA;
            const char* a2 = last ? nA : cA + (ptrdiff_t)(t + 2) * kstepA; const char* b2 = last ? nB : cB + (ptrdiff_t)(t + 2) * kstepB;
            const char* a3 = a2 + kstepA; const char* b3 = b2 + kstepB;
            PG8_LDB(B0, 0, 0); PG8_LDB(B1, 0, 1); PG8_SCHED; PG8_LDA(At, 0, 0); PG8_STAGE(PG8_SA(1, 1), a1 + hstepA, voffA);
            PG8_WAIT_V(8); PG8_WAIT_L(0); PG8_BAR; PG8_MMA(0, 0, At, B0); PG8_MMA(0, 1, At, B1); PG8_BAR; PG8_SCHED;
            PG8_LDA(At, 0, 1); PG8_STAGE(PG8_SB(0, 0), b2, voffB); PG8_STAGE(PG8_SB(0, 1), b2 + hstepB, voffB); PG8_STAGE(PG8_SA(0, 0), a2, voffA);
            PG8_WAIT_V(8); PG8_WAIT_L(0); PG8_BAR; PG8_MMA(1, 0, At, B0); PG8_MMA(1, 1, At, B1); PG8_BAR; PG8_SCHED;
            PG8_LDB(B0, 1, 0); PG8_LDB(B1, 1, 1); PG8_SCHED; PG8_LDA(At, 1, 0); PG8_STAGE(PG8_SA(0, 1), a2 + hstepA, voffA);
            PG8_WAIT_V(8); PG8_WAIT_L(0); PG8_BAR; PG8_MMA(0, 0, At, B0); PG8_MMA(0, 1, At, B1); PG8_BAR; PG8_SCHED;
            PG8_LDA(At, 1, 1); PG8_STAGE(PG8_SB(1, 0), b3, voffB); PG8_STAGE(PG8_SB(1, 1), b3 + hstepB, voffB); PG8_STAGE(PG8_SA(1, 0), a3, voffA);
            PG8_WAIT_V(8); PG8_WAIT_L(0); PG8_BAR; PG8_MMA(1, 0, At, B0); PG8_MMA(1, 1, At, B1); PG8_BAR; PG8_SCHED;
        }
        if (wr == 0) PG8_BAR;
        { int frx = fr, fqx = fq; asm volatile("" : "+v"(frx), "+v"(fqx)); E(acc, cur, wr, wc, frx, fqx); }
        if (!has_next) break;
#pragma unroll
        for (int a = 0; a < 2; ++a)
#pragma unroll
            for (int b = 0; b < 2; ++b)
#pragma unroll
                for (int m = 0; m < 4; ++m)
#pragma unroll
                    for (int n = 0; n < 2; ++n) acc[a][b][m][n] = (f32x4){0.f, 0.f, 0.f, 0.f};
        cur = nxt; cA = nA; cB = nB; ++ui;
        if (wr == 1) PG8_BAR;
    }
    PG8_WAIT_V(0);
    PG8_BAR;
#undef PG8_UA
#undef PG8_UB
#undef PG8_SA
#undef PG8_SB
#undef PG8_STAGE
#undef PG8_LDA
#undef PG8_LDB
#undef PG8_MMA
#undef PG8_WAIT_V
#undef PG8_WAIT_L
#undef PG8_BAR
#undef PG8_SCHED
}

#define EPI_BEGIN \
    _Pragma("unroll") for (int ai = 0; ai < 2; ++ai) _Pragma("unroll") for (int m = 0; m < 4; ++m) { \
        const int row = u.pm * 256 + ai * 128 + wr * 64 + m * 16 + fr; \
        _Pragma("unroll") for (int bj = 0; bj < 2; ++bj) { \
            const int col = u.pn * 256 + bj * 128 + wc * 32 + 8 * fq; \
            f32x4 v0 = acc[ai][bj][m][0], v1 = acc[ai][bj][m][1];
#define EPI_END } if (m == 3) asm volatile("" ::: "memory"); }
#define EPI_SIG const f32x4 (&acc)[2][2][4][2], const Unit& u, int wr, int wc, int fr, int fq

struct EpiStore { bf16_t* O; size_t gs; int ldc;
    __device__ __forceinline__ void operator()(EPI_SIG) const {
        EPI_BEGIN *(u32x4*)(O + (size_t)u.g * gs + (size_t)row * ldc + col) = pack8(v0, v1); EPI_END } };
struct EpiIn { bf16_t* Ug; bf16_t* zx; bf16_t* gates; bf16_t* Kpe; const float* qg; const float* kg; const float* cosT; const float* sinT; LAS unsigned char* lds;
    __device__ __forceinline__ void operator()(EPI_SIG) const {
        if (u.pn < 2) { EPI_BEGIN *(u32x4*)(Ug + ((size_t)((col >> 4) * NCH + (row >> 6)) * 1024 + (row & 63) * 16 + (col & 15))) = pack8(v0, v1); EPI_END }
        else if (u.pn < 4) {
            const bool isq = (u.pn == 2); const int lane = fr + 16 * fq;
            LAS float* red = (LAS float*)(lds + 131072 + 1024);
#pragma unroll
            for (int ai = 0; ai < 2; ++ai)
#pragma unroll
                for (int m = 0; m < 4; ++m) { float p = 0.f;
#pragma unroll
                    for (int bj = 0; bj < 2; ++bj) if (isq || bj == 0) { const f32x4 a = acc[ai][bj][m][0], b = acc[ai][bj][m][1];
                        p += (a[0] * a[0] + a[1] * a[1]) + (a[2] * a[2] + a[3] * a[3]) + (b[0] * b[0] + b[1] * b[1]) + (b[2] * b[2] + b[3] * b[3]); }
                    p += shflx(p, 16, lane); p += shflx(p, 32, lane);
                    if (fq == 0) red[(ai * 128 + wr * 64 + m * 16 + fr) * 4 + wc] = p; }
            asm volatile("s_waitcnt lgkmcnt(0)" ::: "memory"); __builtin_amdgcn_s_barrier(); asm volatile("" ::: "memory");
            const float invn = isq ? (1.0f / 256.0f) : (1.0f / 128.0f);
#pragma unroll
            for (int ai = 0; ai < 2; ++ai)
#pragma unroll
                for (int m = 0; m < 4; ++m) { const int rl = ai * 128 + wr * 64 + m * 16 + fr, row = u.pm * 256 + rl;
                    const f32x4 ps = *(const LAS f32x4*)(red + rl * 4); const float r = rsqrtf(((ps[0] + ps[1]) + (ps[2] + ps[3])) * invn + EPS);
#pragma unroll
                    for (int bj = 0; bj < 2; ++bj) { const int cl = bj * 128 + wc * 32 + 8 * fq; f32x4 v0 = acc[ai][bj][m][0], v1 = acc[ai][bj][m][1];
                        if (isq || bj == 0) { const float* gp = isq ? qg + cl : kg + cl; const f32x4 g0 = *(const f32x4*)gp, g1 = *(const f32x4*)(gp + 4);
                            v0 = v0 * r * g0; v1 = v1 * r * g1; *(u32x4*)(zx + (size_t)row * 512 + (isq ? 0 : 256) + cl) = pack8(v0, v1); }
                        else if (wc == 0) { const int i0 = 4 * fq; const f32x4 c4 = *(const f32x4*)(cosT + (size_t)row * 16 + i0), s4 = *(const f32x4*)(sinT + (size_t)row * 16 + i0);
                            f32x4 o0, o1;
                            o0[0] = v0[0] * c4[0] - v0[1] * s4[0]; o0[1] = v0[1] * c4[0] + v0[0] * s4[0]; o0[2] = v0[2] * c4[1] - v0[3] * s4[1]; o0[3] = v0[3] * c4[1] + v0[2] * s4[1];
                            o1[0] = v1[0] * c4[2] - v1[1] * s4[2]; o1[1] = v1[1] * c4[2] + v1[0] * s4[2]; o1[2] = v1[2] * c4[3] - v1[3] * s4[3]; o1[3] = v1[3] * c4[3] + v1[2] * s4[3];
                            *(u32x4*)(Kpe + (size_t)row * 32 + 8 * fq) = pack8(o0, o1); } } }
            asm volatile("s_waitcnt lgkmcnt(0)" ::: "memory"); __builtin_amdgcn_s_barrier(); asm volatile("" ::: "memory");
        }
        else { EPI_BEGIN
#pragma unroll
            for (int i = 0; i < 4; ++i) { v0[i] = sigmoidf_(v0[i]); v1[i] = sigmoidf_(v1[i]); }
            *(u32x4*)(gates + (size_t)row * 2048 + (col - 1024)) = pack8(v0, v1); EPI_END } } };
struct EpiQ { bf16_t* Q; const float* cosT; const float* sinT; float scale;
    __device__ __forceinline__ void operator()(EPI_SIG) const {
        EPI_BEGIN
            const int head = col / 96, d = col - head * 96;
            v0 = v0 * scale; v1 = v1 * scale;
            if (d >= 64) { const int i0 = (d - 64) >> 1; const f32x4 c4 = *(const f32x4*)(cosT + (size_t)row * 16 + i0), s4 = *(const f32x4*)(sinT + (size_t)row * 16 + i0);
                const f32x4 a = v0, b = v1;
                v0[0] = a[0] * c4[0] - a[1] * s4[0]; v0[1] = a[1] * c4[0] + a[0] * s4[0]; v0[2] = a[2] * c4[1] - a[3] * s4[1]; v0[3] = a[3] * c4[1] + a[2] * s4[1];
                v1[0] = b[0] * c4[2] - b[1] * s4[2]; v1[1] = b[1] * c4[2] + b[0] * s4[2]; v1[2] = b[2] * c4[3] - b[3] * s4[3]; v1[3] = b[3] * c4[3] + b[2] * s4[3]; }
            *(u32x4*)(Q + (size_t)row * 768 + col) = pack8(v0, v1);
        EPI_END } };
struct EpiS { float* S;
    __device__ __forceinline__ void operator()(EPI_SIG) const {
        EPI_BEGIN if (bj == 0) { float* p = S + ((size_t)u.g * NCH + row) * 128 + col; *(f32x4*)p = v0; *(f32x4*)(p + 4) = v1; } EPI_END } };
struct EpiE { const bf16_t* ypart; const bf16_t* Ug; const float* dskip; bf16_t* ya;
    __device__ __forceinline__ void operator()(EPI_SIG) const {
        EPI_BEGIN
            const size_t off = ((size_t)u.g * NCH + row) * 1024 + col;
            f32x4 p0, p1, u0, u1; unpack8(*(const u32x4*)(ypart + off), p0, p1); unpack8(*(const u32x4*)(Ug + off), u0, u1);
            const float* dp = dskip + u.g * 16 + (col & 15); const f32x4 d0 = *(const f32x4*)dp, d1 = *(const f32x4*)(dp + 4);
            v0 = v0 + p0 + d0 * u0; v1 = v1 + p1 + d1 * u1;
#pragma unroll
            for (int i = 0; i < 4; ++i) { v0[i] = gelu_tanh(v0[i]); v1[i] = gelu_tanh(v1[i]); }
            *(u32x4*)(ya + ((size_t)row * 64 + (col >> 4)) * 512 + u.g * 16 + (col & 15)) = pack8(v0, v1);
        EPI_END } };
struct EpiGlu { const bf16_t* ya; const float* bias; bf16_t* yg;
    __device__ __forceinline__ void operator()(EPI_SIG) const {
        EPI_BEGIN
            f32x4 y0, y1; unpack8(*(const u32x4*)(ya + (size_t)row * 512 + col), y0, y1);
            const f32x4 b0 = *(const f32x4*)(bias + col), b1 = *(const f32x4*)(bias + col + 4);
#pragma unroll
            for (int i = 0; i < 4; ++i) { v0[i] = y0[i] * sigmoidf_(v0[i] + b0[i]); v1[i] = y1[i] * sigmoidf_(v1[i] + b1[i]); }
            *(u32x4*)(yg + (size_t)row * 512 + col) = pack8(v0, v1);
        EPI_END } };
template <bool ACCUM> struct EpiMerge { const bf16_t* gates; int goff; bf16_t* mg;
    __device__ __forceinline__ void operator()(EPI_SIG) const {
        EPI_BEGIN
            f32x4 g0, g1; unpack8(*(const u32x4*)(gates + (size_t)row * 2048 + goff + col), g0, g1);
            v0 = v0 * g0; v1 = v1 * g1;
            if (ACCUM) { f32x4 o0, o1; unpack8(*(const u32x4*)(mg + (size_t)row * 1024 + col), o0, o1); v0 = v0 + o0; v1 = v1 + o1; }
            *(u32x4*)(mg + (size_t)row * 1024 + col) = pack8(v0, v1);
        EPI_END } };
struct EpiMerge2 { const bf16_t* gates; bf16_t* mg;
    __device__ __forceinline__ void operator()(EPI_SIG) const {
        if (u.g == 0) { EpiMerge<false> e{gates, 0, mg}; e(acc, u, wr, wc, fr, fq); } else { EpiMerge<true> e{gates, 1024, mg}; e(acc, u, wr, wc, fr, fq); } } };
struct EpiRes { const float* xin; float* xout; const float* gmod;
    __device__ __forceinline__ void operator()(EPI_SIG) const {
        EPI_BEGIN
            const float* gp = gmod + (row >= SEQ ? 6144 : 0) + col; const f32x4 g0 = *(const f32x4*)gp, g1 = *(const f32x4*)(gp + 4);
            const float* xp = xin + (size_t)row * 1024 + col; float* op = xout + (size_t)row * 1024 + col;
            const f32x4 x0 = *(const f32x4*)xp, x1 = *(const f32x4*)(xp + 4);
            *(f32x4*)op = x0 + g0 * v0; *(f32x4*)(op + 4) = x1 + g1 * v1;
        EPI_END } };
struct EpiGU { bf16_t* hid;
    __device__ __forceinline__ void operator()(EPI_SIG) const {
        EPI_BEGIN
#pragma unroll
            for (int i = 0; i < 4; ++i) v0[i] = v0[i] * sigmoidf_(v0[i]) * v1[i];
            u32x2 w; w.x = cvt_pk_bf16(v0[0], v0[1]); w.y = cvt_pk_bf16(v0[2], v0[3]);
            *(u32x2*)(hid + (size_t)row * DFF + (col >> 1)) = w;
        EPI_END } };
}

namespace att {
constexpr int KSTR = 208, VSTR = 144, KBUF = 64 * KSTR, VBUF = 64 * VSTR, OFF_V = 3 * KBUF, OFF_P = OFF_V + 3 * VBUF, LDS_BYTES = OFF_P + 768;
constexpr float NEG = -1.0e30f;

__device__ __forceinline__ void phase(LAS unsigned char* lds, const bf16_t* __restrict__ Q, const bf16_t* __restrict__ Kn, const bf16_t* __restrict__ Kpe, const bf16_t* __restrict__ Vt,
                                      bf16_t* __restrict__ O, const int* __restrict__ pos, const int* __restrict__ tmin, const int* __restrict__ tmax, int G, int c, int tid_in) {
    int tid_ = tid_in; asm volatile("" : "+v"(tid_));
    const int tid = tid_, wave = __builtin_amdgcn_readfirstlane(tid >> 6), lane = tid & 63, q32 = lane & 31, hi = lane >> 5;
    for (int ui = c; ui < 1024; ui += G) {
        const int rnd = ui >> 8, c8 = ui & 255, cc = (G == 256) ? ((2 * (c8 & 7) + (c8 >> 7)) * 16 + ((c8 >> 3) & 15)) : c8, bh = cc >> 4, j16 = cc & 15;
        const int qb = rnd == 0 ? 63 - j16 : rnd == 1 ? 32 + j16 : rnd == 2 ? 31 - j16 : j16;
        const int b = bh >> 3, h = bh & 7;
        const int* tmn = tmin + b * 256; const int* tmx = tmax + b * 256;
        int qmax = tmx[qb * 4], qmin = tmn[qb * 4];
#pragma unroll
        for (int i = 1; i < 4; ++i) { qmax = max(qmax, tmx[qb * 4 + i]); qmin = min(qmin, tmn[qb * 4 + i]); }
        const size_t tok0 = (size_t)b * SEQ;
        const size_t qrow = tok0 + qb * 256 + wave * 32 + q32;
        bf16x8 qf[6];
        { const bf16_t* qp = Q + qrow * 768 + h * 96 + 8 * hi;
#pragma unroll
          for (int j = 0; j < 6; ++j) qf[j] = *(const bf16x8*)(qp + 16 * j); }
        const int posq = pos[qrow];
        f32x16 o0, o1;
#pragma unroll
        for (int r = 0; r < 16; ++r) { o0[r] = 0.f; o1[r] = 0.f; }
        float mrun = NEG, lrun = 0.f;
        const int krow = tid >> 3, kpc = tid & 7, prow = (tid & 255) >> 2, ppc = tid & 3;
        const bf16_t* kn_src = Kn + (tok0 + krow) * 512 + h * 64 + kpc * 8;
        const bf16_t* kp_src = Kpe + (tok0 + prow) * 32 + ppc * 8;
        const bf16_t* vt_src = Vt + (size_t)(h * 64 + krow) * T + tok0 + kpc * 8;
        const int* ps_src = pos + tok0 + (tid & 63);
        unsigned long long vm[4], mm[4];
#pragma unroll
        for (int i = 0; i < 4; ++i) { const int a_ = tmn[lane + 64 * i], b_ = tmx[lane + 64 * i]; vm[i] = __builtin_amdgcn_ballot_w64(a_ <= qmax); mm[i] = __builtin_amdgcn_ballot_w64(b_ > qmin); }
        int it_w = 0; unsigned long long it_c = vm[0], it_m = mm[0];
#define ATT_ITER(res_) do { \
            while (it_c == 0ull && it_w < 3) { ++it_w; it_c = it_w == 1 ? vm[1] : it_w == 2 ? vm[2] : vm[3]; it_m = it_w == 1 ? mm[1] : it_w == 2 ? mm[2] : mm[3]; } \
            if (it_c == 0ull) res_ = 256; \
            else { const int b_ = (int)__builtin_ctzll(it_c); res_ = 64 * it_w + b_ + (int)((it_m >> b_) & 1ull) * 512; it_c &= it_c - 1ull; } } while (0)
        u32x4 rkA, rpA, rvA, rkB, rpB, rvB; int rposA = 0, rposB = 0;
        rpA = (u32x4){0u, 0u, 0u, 0u}; rpB = rpA;
#define ATT_LOAD(S, kt_) do { rk##S = *(const u32x4*)(kn_src + (size_t)(kt_) * 64 * 512); if (tid < 256) rp##S = *(const u32x4*)(kp_src + (size_t)(kt_) * 64 * 32); \
        rv##S = *(const u32x4*)(vt_src + (size_t)(kt_) * 64); if (tid < 64) rpos##S = ps_src[(kt_) * 64]; } while (0)
#define ATT_STORE(S, bf_) do { *(LAS u32x4*)(lds + (bf_) * KBUF + krow * KSTR + kpc * 16) = rk##S; if (tid < 256) *(LAS u32x4*)(lds + (bf_) * KBUF + prow * KSTR + 128 + ppc * 16) = rp##S; \
        LAS unsigned char* vp_ = lds + OFF_V + (bf_) * VBUF + krow * VSTR + (kpc >> 1) * 32 + (kpc & 1) * 8; *(LAS u32x2*)vp_ = (u32x2){rv##S.x, rv##S.y}; *(LAS u32x2*)(vp_ + 16) = (u32x2){rv##S.z, rv##S.w}; \
        if (tid < 64) *(LAS int*)(lds + OFF_P + (bf_) * 256 + tid * 4) = rpos##S; } while (0)
#define ATT_QK(bf_) do { \
            const LAS unsigned char* kb = lds + (bf_) * KBUF + q32 * KSTR + hi * 16; \
            bf16x8 kf0[6], kf1[6]; \
            _Pragma("unroll") for (int j = 0; j < 6; ++j) { kf0[j] = *(const LAS bf16x8*)(kb + j * 32); kf1[j] = *(const LAS bf16x8*)(kb + 32 * KSTR + j * 32); } \
            _Pragma("unroll") for (int r = 0; r < 16; ++r) { s0[r] = 0.f; s1[r] = 0.f; } \
            _Pragma("unroll") for (int j = 0; j < 6; ++j) { s0 = __builtin_amdgcn_mfma_f32_32x32x16_bf16(kf0[j], qf[j], s0, 0, 0, 0); s1 = __builtin_amdgcn_mfma_f32_32x32x16_bf16(kf1[j], qf[j], s1, 0, 0, 0); } \
        } while (0)
#define ATT_SM(bf_, kt_) do { \
            const bool need_mask = ((kt_) & 512) != 0; \
            if (need_mask) { \
                const LAS int* pp = (const LAS int*)(lds + OFF_P + (bf_) * 256) + 4 * hi; \
                _Pragma("unroll") for (int i = 0; i < 4; ++i) { \
                    const i32x4 p0 = *(const LAS i32x4*)(pp + 8 * i), p1 = *(const LAS i32x4*)(pp + 32 + 8 * i); \
                    _Pragma("unroll") for (int e = 0; e < 4; ++e) { if (p0[e] > posq) s0[4 * i + e] = NEG; if (p1[e] > posq) s1[4 * i + e] = NEG; } } } \
            float mx = __builtin_amdgcn_fmed3f(s0[0], s1[0], INFINITY); \
            _Pragma("unroll") for (int r = 1; r < 16; ++r) { mx = __builtin_amdgcn_fmed3f(mx, s0[r], INFINITY); mx = __builtin_amdgcn_fmed3f(mx, s1[r], INFINITY); } \
            mx = __builtin_amdgcn_fmed3f(mx, shflx(mx, 32, lane), INFINITY); \
            if (__builtin_amdgcn_ballot_w64(mx > mrun) != 0ull) { \
                const float mnew = fmaxf(mrun, mx); const float alpha = __builtin_amdgcn_exp2f(mrun - mnew); mrun = mnew; lrun *= alpha; \
                _Pragma("unroll") for (int r = 0; r < 16; ++r) { o0[r] *= alpha; o1[r] *= alpha; } } \
            { const f32x2 m2 = (f32x2){mrun, mrun}; f32x2 ls2 = (f32x2){0.f, 0.f}; \
              _Pragma("unroll") for (int r = 0; r < 16; r += 2) { \
                  f32x2 a_ = (f32x2){s0[r], s0[r + 1]} - m2, b_ = (f32x2){s1[r], s1[r + 1]} - m2; \
                  a_.x = __builtin_amdgcn_exp2f(a_.x); a_.y = __builtin_amdgcn_exp2f(a_.y); b_.x = __builtin_amdgcn_exp2f(b_.x); b_.y = __builtin_amdgcn_exp2f(b_.y); \
                  s0[r] = a_.x; s0[r + 1] = a_.y; s1[r] = b_.x; s1[r + 1] = b_.y; ls2 += a_; ls2 += b_; } \
              lrun += ls2.x + ls2.y; } \
            _Pragma("unroll") for (int jj = 0; jj < 2; ++jj) { \
                u32x4 w0, w1; \
                w0.x = cvt_pk_bf16(s0[8 * jj + 0], s0[8 * jj + 1]); w0.y = cvt_pk_bf16(s0[8 * jj + 2], s0[8 * jj + 3]); w0.z = cvt_pk_bf16(s0[8 * jj + 4], s0[8 * jj + 5]); w0.w = cvt_pk_bf16(s0[8 * jj + 6], s0[8 * jj + 7]); \
                w1.x = cvt_pk_bf16(s1[8 * jj + 0], s1[8 * jj + 1]); w1.y = cvt_pk_bf16(s1[8 * jj + 2], s1[8 * jj + 3]); w1.z = cvt_pk_bf16(s1[8 * jj + 4], s1[8 * jj + 5]); w1.w = cvt_pk_bf16(s1[8 * jj + 6], s1[8 * jj + 7]); \
                pb[0][jj] = __builtin_bit_cast(bf16x8, w0); pb[1][jj] = __builtin_bit_cast(bf16x8, w1); } \
        } while (0)
#define ATT_PV(bf_) do { \
            const LAS unsigned char* vb = lds + OFF_V + (bf_) * VBUF + q32 * VSTR + hi * 16; \
            bf16x8 vfa[4], vfb[4]; \
            _Pragma("unroll") for (int xj = 0; xj < 4; ++xj) { vfa[xj] = *(const LAS bf16x8*)(vb + 32 * xj); vfb[xj] = *(const LAS bf16x8*)(vb + 32 * VSTR + 32 * xj); } \
            _Pragma("unroll") for (int x = 0; x < 2; ++x) _Pragma("unroll") for (int jj = 0; jj < 2; ++jj) { \
                o0 = __builtin_amdgcn_mfma_f32_32x32x16_bf16(vfa[2 * x + jj], pb[x][jj], o0, 0, 0, 0); \
                o1 = __builtin_amdgcn_mfma_f32_32x32x16_bf16(vfb[2 * x + jj], pb[x][jj], o1, 0, 0, 0); } \
        } while (0)
        f32x16 s0, s1; bf16x8 pb[2][2];
        const bool lateg = (wave & 4) != 0;
        int cur, nxt, t2, st = 0, stp = 0; bool havep = false;
        ATT_ITER(cur); nxt = 256; if (cur != 256) ATT_ITER(nxt);
        if (cur != 256) { ATT_LOAD(A, (cur & 255)); ATT_STORE(A, 0); }
        if (nxt != 256) ATT_LOAD(B, (nxt & 255));
        __syncthreads();
        while (cur != 256) {
            { const int st1 = st == 2 ? 0 : st + 1;
              t2 = 256; if (nxt != 256) ATT_ITER(t2);
              if (t2 != 256) ATT_LOAD(A, (t2 & 255));
              if (lateg) { if (havep) ATT_PV(stp); ATT_QK(st); ATT_SM(st, cur); havep = true; stp = st; }
              else { ATT_QK(st); ATT_SM(st, cur); ATT_PV(st); }
              if (nxt != 256) ATT_STORE(B, st1);
              __syncthreads();
              cur = nxt; nxt = t2; st = st1; }
            if (cur == 256) break;
            { const int st1 = st == 2 ? 0 : st + 1;
              t2 = 256; if (nxt != 256) ATT_ITER(t2);
              if (t2 != 256) ATT_LOAD(B, (t2 & 255));
              if (lateg) { if (havep) ATT_PV(stp); ATT_QK(st); ATT_SM(st, cur); havep = true; stp = st; }
              else { ATT_QK(st); ATT_SM(st, cur); ATT_PV(st); }
              if (nxt != 256) ATT_STORE(A, st1);
              __syncthreads();
              cur = nxt; nxt = t2; st = st1; }
        }
        if (lateg && havep) ATT_PV(stp);
        __syncthreads();
        const float ltot = lrun + shflx(lrun, 32, lane);
        const float inv = 1.0f / ltot;
        bf16_t* op = O + qrow * 512 + h * 64 + 4 * hi;
#pragma unroll
        for (int i = 0; i < 4; ++i) {
            u32x2 w; w.x = cvt_pk_bf16(o0[4 * i] * inv, o0[4 * i + 1] * inv); w.y = cvt_pk_bf16(o0[4 * i + 2] * inv, o0[4 * i + 3] * inv);
            *(u32x2*)(op + 8 * i) = w;
            u32x2 w2; w2.x = cvt_pk_bf16(o1[4 * i] * inv, o1[4 * i + 1] * inv); w2.y = cvt_pk_bf16(o1[4 * i + 2] * inv, o1[4 * i + 3] * inv);
            *(u32x2*)(op + 32 + 8 * i) = w2; }
#undef ATT_LOAD
#undef ATT_STORE
#undef ATT_QK
#undef ATT_SM
#undef ATT_PV
#undef ATT_ITER
    }
}
}


constexpr int NWAVES = 8, NTHR = 512;
constexpr int LDS_BYTES = 131072 + 1024 + 4096;

typedef const Params __attribute__((address_space(4)))* KArg;
struct Ctx { int tid, lane, wave, G, c, gw, NGW; LAS unsigned char* lds; };

enum { I_X = 0, I_C, I_POS, I_WADA, I_BADA, I_N1G, I_WIN, I_AR, I_AI, I_LDT, I_BR, I_BI, I_CR, I_CI, I_SD, I_WGLU, I_BGLU, I_WAOUT, I_QNG, I_WUQ, I_KVNG, I_WUK, I_WUV, I_WBOUT, I_WOUT, I_N2G, I_WGATE, I_WUP, I_WDOWN, I_FING };

__device__ __forceinline__ void sincos_acc(double x, float& s, float& c) {
    const double rev = x * 0.15915494309189535; const double r = rev - __builtin_rint(rev);
    const float th = (float)(r * 6.283185307179586);
    s = sinf(th); c = cosf(th);
}
__device__ __forceinline__ float inv_freq_tab(int i) {
    switch (i) { case 0: return 1.0f; case 1: return 0.5623413324356079f; case 2: return 0.3162277638912201f; case 3: return 0.17782793939113617f; case 4: return 0.10000000149011612f;
    case 5: return 0.05623413249850273f; case 6: return 0.03162277489900589f; case 7: return 0.017782794311642647f; case 8: return 0.009999999776482582f; case 9: return 0.005623413249850273f;
    case 10: return 0.003162277629598975f; case 11: return 0.0017782794311642647f; case 12: return 0.0010000000474974513f; case 13: return 0.000562341301701963f; case 14: return 0.0003162277571391314f;
    default: return 0.00017782794020604342f; }
}
__device__ __forceinline__ void p0_mod(const Ctx& X, KArg P) {
    LAS float* sc = (LAS float*)X.lds;
    LAS float* red = sc + 2048;
    const float* cin = P->in[I_C];
    for (int i = X.tid; i < 2048; i += NTHR) { const float v = cin[i]; sc[i] = v * sigmoidf_(v); }
    __syncthreads();
    float* mod = (float*)(P->ws + WS_MOD);
    for (int unit = X.c; unit < DEPTH * 96; unit += X.G) {
        const int l = unit / 96, cb = unit % 96, kp = X.tid >> 6, cj = X.tid & 63, col = cb * 64 + cj;
        const float* w = P->in[I_WADA] + ((size_t)l * 1024 + kp * 128) * 6144 + col;
        float a0 = 0.f, a1 = 0.f;
#pragma unroll 8
        for (int k = 0; k < 128; ++k) { const float wv = w[(size_t)k * 6144]; a0 += sc[kp * 128 + k] * wv; a1 += sc[1024 + kp * 128 + k] * wv; }
        red[(kp * 64 + cj) * 2] = a0; red[(kp * 64 + cj) * 2 + 1] = a1;
        __syncthreads();
        if (X.tid < 128) { const int b = X.tid >> 6, cj2 = X.tid & 63; float s = 0.f;
#pragma unroll
            for (int q = 0; q < 8; ++q) s += red[(q * 64 + cj2) * 2 + b];
            mod[((size_t)l * 2 + b) * 6144 + cb * 64 + cj2] = s + P->in[I_BADA][(size_t)l * 6144 + cb * 64 + cj2]; }
        __syncthreads();
    }
}
__device__ __forceinline__ void p0_tables(const Ctx& X, KArg P) {
    const int* pos = (const int*)P->in[I_POS];
    float* cosT = (float*)(P->ws + WS_ROPE); float* sinT = cosT + (size_t)T * 16;
    for (int idx = X.c * NTHR + X.tid; idx < T * 16; idx += X.G * NTHR) {
        const int tok = idx >> 4, i = idx & 15;
        const float ang = (float)pos[tok] * inv_freq_tab(i);
        float s, c; sincos_acc((double)ang, s, c);
        cosT[idx] = c; sinT[idx] = s;
    }
    int* tmin = (int*)(P->ws + WS_TPOS); int* tmax = tmin + 512;
    for (int t = X.gw; t < 512; t += X.NGW) {
        int v = pos[t * 64 + X.lane], mn = v, mx = v;
#pragma unroll
        for (int o = 1; o < 64; o <<= 1) { mn = min(mn, shflxi(mn, o, X.lane)); mx = max(mx, shflxi(mx, o, X.lane)); }
        if (X.lane == 0) { tmin[t] = mn; tmax[t] = mx; }
    }
}
__device__ __forceinline__ void ssm_stage1(const Ctx& X, KArg P, int l) {
    const float* a_re = P->in[I_AR] + (size_t)l * NG * SP; const float* a_im = P->in[I_AI] + (size_t)l * NG * SP; const float* ldt = P->in[I_LDT] + (size_t)l * NG;
    f32x2* apow = (f32x2*)(P->ws + WS_APOW); f32x2* bbar = (f32x2*)(P->ws + WS_BBAR);
    for (int idx = X.c * NTHR + X.tid; idx < NG * 66 * 64; idx += X.G * NTHR) {
        const int g = idx / (66 * 64), j = (idx >> 6) % 66, p = idx & 63;
        const float n = (j == 65) ? 2048.0f : (float)j;
        const float dt = expf(ldt[g]), ar = a_re[g * 64 + p], ai = a_im[g * 64 + p];
        const float mag = expf(ar * dt * n); float s, c; sincos_acc((double)ai * (double)dt * (double)n, s, c);
        apow[idx] = (f32x2){mag * c, mag * s};
    }
    const float* b_re = P->in[I_BR] + (size_t)l * NG * SP * 16; const float* b_im = P->in[I_BI] + (size_t)l * NG * SP * 16;
    for (int idx = X.c * NTHR + X.tid; idx < NG * 64 * 16; idx += X.G * NTHR) {
        const int g = idx >> 10, p = (idx >> 4) & 63;
        const float dt = expf(ldt[g]), ar = a_re[g * 64 + p], ai = a_im[g * 64 + p];
        const float mag = expf(ar * dt); float s, c; sincos_acc((double)ai * (double)dt, s, c);
        const float nr = mag * c - 1.0f, ni = mag * s, den = ar * ar + ai * ai;
        const float cr = (nr * ar + ni * ai) / den, ci = (ni * ar - nr * ai) / den;
        const float br = b_re[idx], bi = b_im[idx];
        bbar[idx] = (f32x2){cr * br - ci * bi, cr * bi + ci * br};
    }
}
__device__ __forceinline__ void ssm_stage2(const Ctx& X, KArg P, int l) {
    const f32x2* apow = (const f32x2*)(P->ws + WS_APOW); const f32x2* bbar = (const f32x2*)(P->ws + WS_BBAR);
    const float* c_re = P->in[I_CR] + (size_t)l * NG * 16 * SP; const float* c_im = P->in[I_CI] + (size_t)l * NG * 16 * SP;
    bf16_t* Kg = (bf16_t*)(P->ws + WS_KG); bf16_t* Et = (bf16_t*)(P->ws + WS_ET); bf16_t* Ft = (bf16_t*)(P->ws + WS_FT);
    for (int idx = X.c * NTHR + X.tid; idx < NG * 128 * 64; idx += X.G * NTHR) {
        const int g = idx >> 13, jj = (idx >> 6) & 127, m = (idx >> 2) & 15, mq = idx & 3;
        f32x4 acc = (f32x4){0.f, 0.f, 0.f, 0.f};
        if (jj >= 64) { const int j = jj - 64;
            const float* cr = c_re + (g * 16 + m) * 64; const float* ci = c_im + (g * 16 + m) * 64; const f32x2* ap = apow + (g * 66 + j) * 64; const f32x4* bb = (const f32x4*)(bbar + (size_t)g * 1024 + 4 * mq);
#pragma unroll 4
            for (int p = 0; p < 64; ++p) { const f32x2 a = ap[p]; const f32x4 b01 = bb[p * 8], b23 = bb[p * 8 + 1]; const float wr = cr[p] * a.x - ci[p] * a.y, wi = cr[p] * a.y + ci[p] * a.x;
                acc[0] += wr * b01[0] - wi * b01[1]; acc[1] += wr * b01[2] - wi * b01[3]; acc[2] += wr * b23[0] - wi * b23[1]; acc[3] += wr * b23[2] - wi * b23[3]; } }
        u32x2 w; w.x = cvt_pk_bf16(acc[0], acc[1]); w.y = cvt_pk_bf16(acc[2], acc[3]);
        *(u32x2*)(Kg + (size_t)idx * 4) = w;
    }
    for (int idx = X.c * NTHR + X.tid; idx < NG * 1024 * 128; idx += X.G * NTHR) {
        const int g = idx >> 17, n = (idx >> 7) & 1023, k = idx & 127, t = n >> 4, m = n & 15, p = k & 63;
        const f32x2 a = apow[(g * 66 + t + 1) * 64 + p]; const float cr = c_re[(g * 16 + m) * 64 + p], ci = c_im[(g * 16 + m) * 64 + p];
        const float wr = cr * a.x - ci * a.y, wi = cr * a.y + ci * a.x;
        Et[idx] = f2bf(k < 64 ? wr : -wi);
    }
    for (int idx = X.c * NTHR + X.tid; idx < NG * 128 * 1024; idx += X.G * NTHR) {
        const int g = idx >> 17, n = (idx >> 10) & 127, k = idx & 1023, s = k >> 4, mp = k & 15, p = n & 63;
        const f32x2 a = apow[(g * 66 + 63 - s) * 64 + p], b2 = bbar[(size_t)g * 1024 + p * 16 + mp];
        Ft[idx] = f2bf(n < 64 ? (a.x * b2.x - a.y * b2.y) : (a.x * b2.y + a.y * b2.x));
    }
}
struct SrcCol { const float* p; int ld; };
__device__ __forceinline__ SrcCol src_col(KArg P, int l, int mat, int n) {
    SrcCol r; r.p = nullptr; r.ld = 0;
    switch (mat) {
    case 0: { int s = -1; if (n < 896) s = n; else if (n < 928) { const int i = n - 896; s = 896 + (i >> 1) + (i & 1) * 16; } else if (n < 1024) s = -1; else if (n < 2048) s = 928 + (n - 1024); else s = 1952 + (n - 2048);
              r.ld = INC; if (s >= 0) r.p = P->in[I_WIN] + (size_t)l * 1024 * INC + s; } break;
    case 1: r.ld = 512; r.p = P->in[I_WGLU] + (size_t)l * 512 * 512 + n; break;
    case 2: r.ld = 1024; r.p = P->in[I_WAOUT] + (size_t)l * 512 * 1024 + n; break;
    case 3: r.ld = 1024; r.p = P->in[I_WBOUT] + (size_t)l * 512 * 1024 + n; break;
    case 4: { const int h = n / 96, d = n - h * 96; int s = n; if (d >= 64) { const int i = d - 64; s = h * 96 + 64 + (i >> 1) + (i & 1) * 16; }
              r.ld = 768; r.p = P->in[I_WUQ] + (size_t)l * 256 * 768 + s; } break;
    case 5: r.ld = 512; r.p = P->in[I_WUK] + (size_t)l * 128 * 512 + n; break;
    case 6: r.ld = 512; r.p = P->in[I_WUV] + (size_t)l * 128 * 512 + n; break;
    case 7: r.ld = 1024; r.p = P->in[I_WOUT] + (size_t)l * 1024 * 1024 + n; break;
    case 8: { const int g8 = n >> 3, q = n & 7; r.ld = DFF; r.p = (q < 4 ? P->in[I_WGATE] + (size_t)l * 1024 * DFF + 4 * g8 + q : P->in[I_WUP] + (size_t)l * 1024 * DFF + 4 * g8 + (q - 4)); } break;
    default: r.ld = 1024; r.p = P->in[I_WDOWN] + (size_t)l * DFF * 1024 + n; break;
    }
    return r;
}
template <int MAT, int K, int N>
__device__ __forceinline__ void weights_mat(const Ctx& X, KArg P, int l, bf16_t* Wdst, LAS float* scr, int base) {
    constexpr int nblk = N / 32, items = (K / 64) * nblk;
    const int first = ((X.gw - base) % X.NGW + X.NGW) % X.NGW;
    for (int it = first; it < items; it += X.NGW) {
        const int kb = it / nblk, nb = it % nblk, k0 = 64 * kb, n0 = 32 * nb;
        const SrcCol sc = src_col(P, l, MAT, n0 + (X.lane & 31));
#pragma unroll 32
        for (int i = 0; i < 32; ++i) { const int kk = 2 * i + (X.lane >> 5); scr[kk * 33 + (X.lane & 31)] = sc.p ? sc.p[(size_t)(k0 + kk) * sc.ld] : 0.f; }
        asm volatile("s_waitcnt lgkmcnt(0)" ::: "memory");
        const int ck = X.lane & 7;
#pragma unroll
        for (int j = 0; j < 4; ++j) { const int n = (X.lane >> 3) + 8 * j; const LAS float* s = scr + (8 * ck) * 33 + n;
            u32x4 o; o.x = cvt_pk_bf16(s[0], s[33]); o.y = cvt_pk_bf16(s[2 * 33], s[3 * 33]); o.z = cvt_pk_bf16(s[4 * 33], s[5 * 33]); o.w = cvt_pk_bf16(s[6 * 33], s[7 * 33]);
            *(u32x4*)(Wdst + (size_t)(n0 + n) * K + k0 + 8 * ck) = o; }
        asm volatile("s_waitcnt lgkmcnt(0)" ::: "memory");
    }
}
__device__ __forceinline__ void weights_phase(const Ctx& X, KArg P, int l) {
    bf16_t* W = (bf16_t*)(P->ws + WS_W);
    LAS float* scr = (LAS float*)(X.lds + X.wave * 8448);
    constexpr int I0 = 16 * 96, I1 = 8 * 16, I2 = 8 * 32, I3 = 8 * 32, I4 = 4 * 24, I5 = 2 * 16, I6 = 2 * 16, I7 = 16 * 32, I8 = 16 * 176;
    weights_mat<0, 1024, 3072>(X, P, l, W + WO_IN, scr, 0);
    weights_mat<1, 512, 512>(X, P, l, W + WO_GLU, scr, I0);
    weights_mat<2, 512, 1024>(X, P, l, W + WO_A, scr, I0 + I1);
    weights_mat<3, 512, 1024>(X, P, l, W + WO_B, scr, I0 + I1 + I2);
    weights_mat<4, 256, 768>(X, P, l, W + WO_UQ, scr, I0 + I1 + I2 + I3);
    weights_mat<5, 128, 512>(X, P, l, W + WO_UK, scr, I0 + I1 + I2 + I3 + I4);
    weights_mat<6, 128, 512>(X, P, l, W + WO_UV, scr, I0 + I1 + I2 + I3 + I4 + I5);
    weights_mat<7, 1024, 1024>(X, P, l, W + WO_OUT, scr, I0 + I1 + I2 + I3 + I4 + I5 + I6);
    weights_mat<8, 1024, 5632>(X, P, l, W + WO_GU, scr, I0 + I1 + I2 + I3 + I4 + I5 + I6 + I7);
    weights_mat<9, DFF, 1024>(X, P, l, W + WO_DOWN, scr, I0 + I1 + I2 + I3 + I4 + I5 + I6 + I7 + I8);
}
__device__ __forceinline__ void norm_phase(const Ctx& X, const float* x, const float* gain, const float* mod_sh, const float* mod_sc, bf16_t* h) {
    for (int row0 = X.gw; row0 < T; row0 += 2 * X.NGW) {
        const int row1 = row0 + X.NGW;
        const bool has1 = row1 < T;
        const f32x4* xr0 = (const f32x4*)(x + (size_t)row0 * 1024) + X.lane;
        const f32x4* xr1 = (const f32x4*)(x + (size_t)(has1 ? row1 : row0) * 1024) + X.lane;
        f32x4 v0[4], v1[4]; float ss0 = 0.f, ss1 = 0.f;
#pragma unroll
        for (int j = 0; j < 4; ++j) { v0[j] = xr0[64 * j]; v1[j] = xr1[64 * j]; }
#pragma unroll
        for (int j = 0; j < 4; ++j) { ss0 += (v0[j][0] * v0[j][0] + v0[j][1] * v0[j][1]) + (v0[j][2] * v0[j][2] + v0[j][3] * v0[j][3]);
                                      ss1 += (v1[j][0] * v1[j][0] + v1[j][1] * v1[j][1]) + (v1[j][2] * v1[j][2] + v1[j][3] * v1[j][3]); }
#pragma unroll
        for (int o = 1; o < 64; o <<= 1) { ss0 += shflx(ss0, o, X.lane); ss1 += shflx(ss1, o, X.lane); }
        const float r0 = rsqrtf(ss0 * (1.0f / 1024.0f) + EPS), r1 = rsqrtf(ss1 * (1.0f / 1024.0f) + EPS);
        const int bo0 = row0 >= SEQ ? 6144 : 0, bo1 = row1 >= SEQ ? 6144 : 0;
#pragma unroll
        for (int j = 0; j < 4; ++j) { const int col = 256 * j + 4 * X.lane;
            const f32x4 g4 = *(const f32x4*)(gain + col);
            { const f32x4 s4 = *(const f32x4*)(mod_sc + bo0 + col), h4 = *(const f32x4*)(mod_sh + bo0 + col);
              const f32x4 o = v0[j] * r0 * g4 * (s4 + 1.0f) + h4; u32x2 w; w.x = cvt_pk_bf16(o[0], o[1]); w.y = cvt_pk_bf16(o[2], o[3]);
              *(u32x2*)(h + (size_t)row0 * 1024 + col) = w; }
            if (has1) { const f32x4 s4 = *(const f32x4*)(mod_sc + bo1 + col), h4 = *(const f32x4*)(mod_sh + bo1 + col);
              const f32x4 o = v1[j] * r1 * g4 * (s4 + 1.0f) + h4; u32x2 w; w.x = cvt_pk_bf16(o[0], o[1]); w.y = cvt_pk_bf16(o[2], o[3]);
              *(u32x2*)(h + (size_t)row1 * 1024 + col) = w; } }
    }
}
__device__ __forceinline__ void final_norm_phase(const Ctx& X, float* x, const float* gain) {
    for (int row0 = X.gw; row0 < T; row0 += 2 * X.NGW) {
        const int row1 = row0 + X.NGW; const bool has1 = row1 < T;
        f32x4* xr0 = (f32x4*)(x + (size_t)row0 * 1024) + X.lane; f32x4* xr1 = (f32x4*)(x + (size_t)(has1 ? row1 : row0) * 1024) + X.lane;
        f32x4 v0[4], v1[4]; float ss0 = 0.f, ss1 = 0.f;
#pragma unroll
        for (int j = 0; j < 4; ++j) { v0[j] = xr0[64 * j]; v1[j] = xr1[64 * j]; }
#pragma unroll
        for (int j = 0; j < 4; ++j) { ss0 += (v0[j][0] * v0[j][0] + v0[j][1] * v0[j][1]) + (v0[j][2] * v0[j][2] + v0[j][3] * v0[j][3]);
                                      ss1 += (v1[j][0] * v1[j][0] + v1[j][1] * v1[j][1]) + (v1[j][2] * v1[j][2] + v1[j][3] * v1[j][3]); }
#pragma unroll
        for (int o = 1; o < 64; o <<= 1) { ss0 += shflx(ss0, o, X.lane); ss1 += shflx(ss1, o, X.lane); }
        const float r0 = rsqrtf(ss0 * (1.0f / 1024.0f) + EPS), r1 = rsqrtf(ss1 * (1.0f / 1024.0f) + EPS);
#pragma unroll
        for (int j = 0; j < 4; ++j) { const f32x4 g4 = *(const f32x4*)(gain + 256 * j + 4 * X.lane); xr0[64 * j] = v0[j] * r0 * g4; if (has1) xr1[64 * j] = v1[j] * r1 * g4; }
    }
}
__device__ __forceinline__ void prep_phase(const Ctx& X, KArg P, int l) {
    bf16_t* zx = (bf16_t*)(P->ws + WS_ZX); bf16_t* Kpe = (bf16_t*)(P->ws + WS_KPE);
    const float* cosT = (const float*)(P->ws + WS_ROPE); const float* sinT = cosT + (size_t)T * 16;
    const float* qg = P->in[I_QNG] + (size_t)l * QL; const float* kg = P->in[I_KVNG] + (size_t)l * KVL;
    for (int row = X.gw; row < T; row += X.NGW) {
        bf16_t* zr = zx + (size_t)row * 512;
        const u32x2 cq = *(const u32x2*)(zr + 4 * X.lane); const unsigned ck = *(const unsigned*)(zr + 256 + 2 * X.lane);
        const float q0 = bflo(cq.x), q1 = bfhi(cq.x), q2 = bflo(cq.y), q3 = bfhi(cq.y), k0 = bflo(ck), k1 = bfhi(ck);
        const float rq = rsqrtf(wave_sum((q0 * q0 + q1 * q1) + (q2 * q2 + q3 * q3), X.lane) * (1.0f / 256.0f) + EPS);
        const float rk = rsqrtf(wave_sum(k0 * k0 + k1 * k1, X.lane) * (1.0f / 128.0f) + EPS);
        const f32x4 g4 = *(const f32x4*)(qg + 4 * X.lane); const f32x2 g2 = *(const f32x2*)(kg + 2 * X.lane);
        u32x2 wq; wq.x = cvt_pk_bf16(q0 * rq * g4[0], q1 * rq * g4[1]); wq.y = cvt_pk_bf16(q2 * rq * g4[2], q3 * rq * g4[3]);
        const unsigned wk = cvt_pk_bf16(k0 * rk * g2[0], k1 * rk * g2[1]);
        if (X.lane < 16) { const unsigned kr = *(const unsigned*)(zr + 384 + 2 * X.lane); const float x1 = bflo(kr), x2 = bfhi(kr);
            const float c = cosT[(size_t)row * 16 + X.lane], s = sinT[(size_t)row * 16 + X.lane];
            *(unsigned*)(Kpe + (size_t)row * 32 + 2 * X.lane) = cvt_pk_bf16(x1 * c - x2 * s, x2 * c + x1 * s); }
        *(u32x2*)(zr + 4 * X.lane) = wq; *(unsigned*)(zr + 256 + 2 * X.lane) = wk;
    }
}
__device__ __forceinline__ void carry_phase(const Ctx& X, KArg P) {
    const float* S = (const float*)(P->ws + WS_S); bf16_t* Hc = (bf16_t*)(P->ws + WS_HC); const f32x2* apow = (const f32x2*)(P->ws + WS_APOW);
    LAS f32x2* Ew = (LAS f32x2*)X.lds;
    const int cshift = X.G >= 64 ? X.G - 64 : 0;
    for (int i = X.c - cshift; i < 64; i += X.G) {
        if (i < 0) break;
        const int b = i >> 5, g = i & 31, p = X.lane, w = X.wave;
        const f32x2 a64 = apow[(g * 66 + 64) * 64 + p], a2k = apow[(g * 66 + 65) * 64 + p];
        const size_t r0 = ((size_t)g * NCH + b * 256 + w * 32) * 128;
        float sre[32], sim[32];
#pragma unroll
        for (int cc = 0; cc < 32; ++cc) { sre[cc] = S[r0 + cc * 128 + p]; sim[cc] = S[r0 + cc * 128 + 64 + p]; }
        float hr = 0.f, hi = 0.f;
#pragma unroll
        for (int cc = 0; cc < 32; ++cc) { const float nr = a64.x * hr - a64.y * hi + sre[cc], ni = a64.x * hi + a64.y * hr + sim[cc]; hr = nr; hi = ni; }
        Ew[w * 64 + p] = (f32x2){hr, hi};
        __syncthreads();
        hr = 0.f; hi = 0.f;
        for (int q = 0; q < w; ++q) { const f32x2 e = Ew[q * 64 + p]; const float nr = a2k.x * hr - a2k.y * hi + e.x, ni = a2k.x * hi + a2k.y * hr + e.y; hr = nr; hi = ni; }
#pragma unroll
        for (int cc = 0; cc < 32; ++cc) {
            Hc[r0 + cc * 128 + p] = f2bf(hr); Hc[r0 + cc * 128 + 64 + p] = f2bf(hi);
            const float nr = a64.x * hr - a64.y * hi + sre[cc], ni = a64.x * hi + a64.y * hr + sim[cc]; hr = nr; hi = ni; }
        __syncthreads();
    }
}

#ifndef PHMASK
#define PHMASK 0xffffffffu
#endif
__global__ void __launch_bounds__(NTHR, 2) trunk_fwd(Params Pval) {
    extern __shared__ __attribute__((aligned(16))) unsigned char lds_raw[];
    cg::grid_group grid = cg::this_grid();
    Ctx X; X.lds = (LAS unsigned char*)lds_raw; X.tid = threadIdx.x; X.lane = X.tid & 63; X.wave = __builtin_amdgcn_readfirstlane(X.tid >> 6);
    X.G = gridDim.x; X.c = blockIdx.x; X.gw = X.c * NWAVES + X.wave; X.NGW = X.G * NWAVES;
    using pg8::Gemm; using pg8::Order;
    KArg P = (KArg)__builtin_amdgcn_kernarg_segment_ptr();
    unsigned char* ws;
    unsigned bar_epoch = 0;
#ifdef PROBE_PHASE
    unsigned long long probe_acc = 0, probe_t = 0; int probe_seg = -1;
#define PROBE_TICK() do { const unsigned long long now_ = __builtin_amdgcn_s_memrealtime(); if (probe_seg >= 0 && probe_seg < 16 && ((PROBE_PHASE >> probe_seg) & 1)) probe_acc += now_ - probe_t; probe_t = now_; ++probe_seg; } while (0)
#else
#define PROBE_TICK() do {} while (0)
#endif
    const unsigned my_xcc = (unsigned)__builtin_amdgcn_s_getreg((3 << 11) | 20) & 0xFu;
    volatile LAS unsigned* const bar_lds = (volatile LAS unsigned*)(X.lds + 131072);
#define BAR_LD(p) __hip_atomic_load((p), __ATOMIC_RELAXED, __HIP_MEMORY_SCOPE_AGENT)
#define BAR_ADD(p, v) __hip_atomic_fetch_add((p), (v), __ATOMIC_RELAXED, __HIP_MEMORY_SCOPE_AGENT)
    {
        unsigned* const bw = (unsigned*)(P->ws + WS_BAR);
        if (X.tid == 0) { BAR_ADD(bw + 64 * my_xcc, 1u); BAR_ADD(bw + 3200, 1u); while (BAR_LD(bw + 3200) < (unsigned)X.G) __builtin_amdgcn_s_sleep(1);
            unsigned nl = 1, nxc = 0;
            for (unsigned j = 0; j < 16; ++j) { const unsigned cj = BAR_LD(bw + 64 * j); if (cj) ++nxc; if (j == my_xcc) nl = cj; }
            bar_lds[0] = nl; bar_lds[1] = nxc ? nxc : 1u; }
        __syncthreads();
    }
#define GRID_SYNC() do { asm volatile("s_waitcnt vmcnt(0)" ::: "memory"); __syncthreads(); \
        asm volatile("" : "+s"(P)); unsigned* const bw_ = (unsigned*)(P->ws + WS_BAR); \
        unsigned lb_ = (unsigned)(size_t)X.lds + 131072u; asm volatile("" : "+s"(lb_)); unsigned xc_ = my_xcc; asm volatile("" : "+s"(xc_)); \
        if (X.tid == 0) { const unsigned nl_ = ((volatile LAS unsigned*)lb_)[0], nx_ = ((volatile LAS unsigned*)lb_)[1], k_ = bar_epoch; \
            const unsigned old_ = BAR_ADD(bw_ + 1024 + 64 * xc_, 1u); \
            if (old_ + 1u == (k_ + 1u) * nl_) { __builtin_amdgcn_fence(__ATOMIC_RELEASE, "agent"); asm volatile("s_waitcnt vmcnt(0)" ::: "memory"); \
                const unsigned og_ = BAR_ADD(bw_ + 3072, 1u); \
                if (og_ + 1u == (k_ + 1u) * nx_) BAR_ADD(bw_ + 3136, 1u); else while (BAR_LD(bw_ + 3136) <= k_) __builtin_amdgcn_s_sleep(1); \
                __builtin_amdgcn_fence(__ATOMIC_ACQUIRE, "agent"); BAR_ADD(bw_ + 2048 + 64 * xc_, 1u); asm volatile("s_waitcnt vmcnt(0)" ::: "memory"); } \
            else { while (BAR_LD(bw_ + 2048 + 64 * xc_) <= k_) __builtin_amdgcn_s_sleep(1); __builtin_amdgcn_fence(__ATOMIC_ACQUIRE, "agent"); asm volatile("s_waitcnt vmcnt(0)" ::: "memory"); } } \
        bar_epoch += 1; __syncthreads(); PROBE_TICK(); } while (0)
#define FRESH() do { asm volatile("" : "+s"(P)); asm volatile("v_mbcnt_lo_u32_b32 %0, -1, 0\n\tv_mbcnt_hi_u32_b32 %0, -1, %0" : "=v"(X.lane)); X.tid = X.wave * 64 + X.lane; ws = P->ws; } while (0)
#define mod ((float*)(ws + WS_MOD))
#define cosT ((const float*)(ws + WS_ROPE))
#define sinT (cosT + (size_t)T * 16)
#define tmin ((const int*)(ws + WS_TPOS))
#define tmax (tmin + 512)
#define Wb ((bf16_t*)(ws + WS_W))
#define Hb ((bf16_t*)(ws + WS_H))
#define Ug ((bf16_t*)(ws + WS_UG))
#define zx ((bf16_t*)(ws + WS_ZX))
#define gates ((bf16_t*)(ws + WS_GATES))
#define Qb ((bf16_t*)(ws + WS_Q))
#define Kn ((bf16_t*)(ws + WS_KN))
#define Kpe ((bf16_t*)(ws + WS_KPE))
#define Vt ((bf16_t*)(ws + WS_VT))
#define Ob ((bf16_t*)(ws + WS_O))
#define ypart ((bf16_t*)(ws + WS_YPART))
#define ya ((bf16_t*)(ws + WS_YA))
#define yg ((bf16_t*)(ws + WS_YG))
#define hid ((bf16_t*)(ws + WS_HID))
#define Sb ((float*)(ws + WS_S))
#define Hc ((bf16_t*)(ws + WS_HC))
#define modl (mod + (size_t)l * 2 * 6144)
#define xin ((l == 0) ? P->in[I_X] : (const float*)P->out)

#define PH(n) if (PHMASK & (1u << (n)))
    grid.sync();
    PH(0) { FRESH(); p0_mod(X, P); p0_tables(X, P); weights_phase(X, P, 0); ssm_stage1(X, P, 0); }
    GRID_SYNC();

    for (int l = 0; l < DEPTH; ++l) {
#ifdef PROBE_PHASE
        probe_seg = 0;
#endif
        if (l > 0) PH(1) { FRESH(); weights_phase(X, P, l); ssm_stage1(X, P, l); }
        PH(2) { FRESH(); norm_phase(X, xin, P->in[I_N1G] + (size_t)l * 1024, modl + 0, modl + 1024, Hb); }
        GRID_SYNC();
        PH(3) { FRESH(); ssm_stage2(X, P, l); }
        PH(4) { FRESH(); Gemm g{Hb, Wb + WO_IN, 1024, 1024, 0, 0, 1024}; Order S; S.init(T, 3072, 1, X.G, X.c); pg8::EpiIn E{Ug, zx, gates, Kpe, P->in[I_QNG] + (size_t)l * QL, P->in[I_KVNG] + (size_t)l * KVL, cosT, sinT, X.lds};
          pg8::gemm_phase<pg8::EpiIn, false>(X.lds, g, S, E, X.tid); }
        GRID_SYNC();
        PH(6) { FRESH(); Gemm g{Ug, (const bf16_t*)(ws + WS_FT), 1024, 1024, (size_t)NCH * 1024, (size_t)128 * 1024, 1024}; Order S; S.init(NCH, 256, NG, X.G, X.c); pg8::EpiS E{Sb};
          pg8::gemm_phase<pg8::EpiS, false>(X.lds, g, S, E, X.tid); }
        GRID_SYNC();
        PH(7) { FRESH(); carry_phase(X, P); }
        PH(8) { FRESH(); Gemm g{zx, Wb + WO_UQ, 512, 256, 0, 0, 256}; Order S; S.init(T, 768, 1, X.G, X.c); pg8::EpiQ E{Qb, cosT, sinT, 0.10206207261596577f * 1.4426950408889634f};
          pg8::gemm_phase<pg8::EpiQ, false>(X.lds, g, S, E, X.tid); }
        PH(9) { FRESH(); Gemm g{zx + 256, Wb + WO_UK, 512, 128, 0, 0, 128}; Order S; S.init(T, 512, 1, X.G, X.c); pg8::EpiStore E{Kn, 0, 512};
          pg8::gemm_phase<pg8::EpiStore, false>(X.lds, g, S, E, X.tid); }
        PH(10) { FRESH(); Gemm g{Wb + WO_UV, zx + 256, 128, 512, 0, 0, 128}; Order S; S.init(512, T, 1, X.G, X.c); pg8::EpiStore E{Vt, 0, T};
          pg8::gemm_phase<pg8::EpiStore, false>(X.lds, g, S, E, X.tid); }
        GRID_SYNC();
#ifdef ATT_DUMMY
        PH(11) { FRESH(); for (int idx = X.c * NTHR + X.tid; idx < T * 512; idx += X.G * NTHR) { const int row = idx >> 9, cc = idx & 511, h = cc >> 6, d = cc & 63;
            const float v = bf2f(Qb[(size_t)row * 768 + h * 96 + d]) + bf2f(Qb[(size_t)row * 768 + h * 96 + 64 + (d & 31)]) + bf2f(Kn[(size_t)row * 512 + cc]) + bf2f(Vt[(size_t)cc * T + row]) + bf2f(Kpe[(size_t)row * 32 + (d & 31)]);
            Ob[idx] = f2bf(v * 0.25f); } }
#else
        PH(11) { FRESH(); att::phase(X.lds, Qb, Kn, Kpe, Vt, Ob, (const int*)P->in[I_POS], tmin, tmax, X.G, X.c, X.tid); }
#endif
#ifdef SYNC_AFTER_ATT
        GRID_SYNC();
#endif
        PH(12) { FRESH(); Gemm g{Ug, (const bf16_t*)(ws + WS_KG) + 16384, 1024, 16, (size_t)NCH * 1024, 32768, 1024}; Order S; S.init(NCH, 1024, NG, X.G, X.c); pg8::EpiStore E{ypart, (size_t)NCH * 1024, 1024};
          pg8::gemm_phase<pg8::EpiStore, true>(X.lds, g, S, E, X.tid); }
        PH(13) { FRESH(); Gemm g{Hc, (const bf16_t*)(ws + WS_ET), 128, 128, (size_t)NCH * 128, (size_t)1024 * 128, 128}; Order S; S.init(NCH, 1024, NG, X.G, X.c);
          pg8::EpiE E{ypart, Ug, P->in[I_SD] + (size_t)l * SW, ya};
          pg8::gemm_phase<pg8::EpiE, false>(X.lds, g, S, E, X.tid); }
        GRID_SYNC();
        PH(14) { FRESH(); Gemm g{ya, Wb + WO_GLU, 512, 512, 0, 0, 512}; Order S; S.init(T, 512, 1, X.G, X.c); pg8::EpiGlu E{ya, P->in[I_BGLU] + (size_t)l * SW, yg};
          pg8::gemm_phase<pg8::EpiGlu, false>(X.lds, g, S, E, X.tid); }
        GRID_SYNC();
        if ((512 % X.G) == 0) {
        PH(15) { FRESH(); Gemm g{yg, Wb + WO_A, 512, 512, (size_t)(WS_O - WS_YG) / 2, (size_t)(WO_B - WO_A), 512}; Order S; S.init(T, 1024, 2, X.G, X.c); pg8::EpiMerge2 E{gates, Hb};
          pg8::gemm_phase<pg8::EpiMerge2, false>(X.lds, g, S, E, X.tid); }
        } else {
        PH(15) { FRESH(); Gemm g{yg, Wb + WO_A, 512, 512, 0, 0, 512}; Order S; S.init(T, 1024, 1, X.G, X.c); pg8::EpiMerge<false> E{gates, 0, Hb};
          pg8::gemm_phase<pg8::EpiMerge<false>, false>(X.lds, g, S, E, X.tid); }
        GRID_SYNC();
        PH(16) { FRESH(); Gemm g{Ob, Wb + WO_B, 512, 512, 0, 0, 512}; Order S; S.init(T, 1024, 1, X.G, X.c); pg8::EpiMerge<true> E{gates, 1024, Hb};
          pg8::gemm_phase<pg8::EpiMerge<true>, false>(X.lds, g, S, E, X.tid); }
        }
        GRID_SYNC();
        PH(17) { FRESH(); Gemm g{Hb, Wb + WO_OUT, 1024, 1024, 0, 0, 1024}; Order S; S.init(T, 1024, 1, X.G, X.c); pg8::EpiRes E{xin, P->out, modl + 2048};
          pg8::gemm_phase<pg8::EpiRes, false>(X.lds, g, S, E, X.tid); }
        GRID_SYNC();
        PH(18) { FRESH(); norm_phase(X, P->out, P->in[I_N2G] + (size_t)l * 1024, modl + 3072, modl + 4096, Hb); }
        GRID_SYNC();
        PH(19) { FRESH(); Gemm g{Hb, Wb + WO_GU, 1024, 1024, 0, 0, 1024}; Order S; S.init(T, 5632, 1, X.G, X.c); pg8::EpiGU E{hid};
          pg8::gemm_phase<pg8::EpiGU, false>(X.lds, g, S, E, X.tid); }
        GRID_SYNC();
        PH(20) { FRESH(); Gemm g{hid, Wb + WO_DOWN, DFF, DFF, 0, 0, DFF}; Order S; S.init(T, 1024, 1, X.G, X.c); pg8::EpiRes E{P->out, P->out, modl + 5120};
          pg8::gemm_phase<pg8::EpiRes, false>(X.lds, g, S, E, X.tid); }
        GRID_SYNC();
    }
    PH(21) { FRESH(); final_norm_phase(X, P->out, P->in[I_FING]); }
#ifdef PROBE_PHASE
    GRID_SYNC(); if (blockIdx.x == 0 && X.tid == 0) P->out[0] = PROBE_Q * (float)(int)((float)probe_acc * 0.01f / PROBE_Q + 0.5f);
#endif
}

extern "C" void kernel_launch(void* const* d_in, const int* in_sizes, int n_in, void* d_out, int out_size, void* d_ws, size_t ws_size, hipStream_t stream) {
    static int grid_blocks = 0;
    if (grid_blocks == 0) {
        if (n_in != 30 || ws_size < WS_END) { fprintf(stderr, "kernel_launch: unexpected n_in %d / ws_size %zu (need %zu)\n", n_in, ws_size, (size_t)WS_END); grid_blocks = -1; return; }
        int dev = 0, cus = 0, per_cu = 0;
        hipGetDevice(&dev);
        hipDeviceGetAttribute(&cus, hipDeviceAttributeMultiprocessorCount, dev);
        if (hipFuncSetAttribute((const void*)trunk_fwd, hipFuncAttributeMaxDynamicSharedMemorySize, LDS_BYTES) != hipSuccess) fprintf(stderr, "kernel_launch: hipFuncSetAttribute failed\n");
        hipOccupancyMaxActiveBlocksPerMultiprocessor(&per_cu, (const void*)trunk_fwd, NTHR, LDS_BYTES);
        if (per_cu < 1) per_cu = 1;
        grid_blocks = cus * per_cu;
        fprintf(stderr, "kernel_launch: cus %d per_cu %d grid %d\n", cus, per_cu, grid_blocks);
    }
    if (grid_blocks < 0) return;
    if (hipMemsetAsync((char*)d_ws + WS_BAR, 0, 16384, stream) != hipSuccess) fprintf(stderr, "kernel_launch: memset failed\n");
    Params p{};
    for (int i = 0; i < 30; ++i) p.in[i] = (const float*)d_in[i];
    p.out = (float*)d_out; p.ws = (unsigned char*)d_ws;
    void* args[] = {&p};
    hipError_t e = hipLaunchCooperativeKernel((const void*)trunk_fwd, dim3(grid_blocks), dim3(NTHR), args, LDS_BYTES, stream);
    if (e != hipSuccess) fprintf(stderr, "cooperative launch failed: %s (grid %d)\n", hipGetErrorString(e), grid_blocks);
}
```
